# Optimizing an MI355X kernel written in HIP

```python
import math
import jax
import jax.numpy as jnp
from jax import lax
import numpy as np

D_MODEL = 1024
BATCH = 8
SEQ = 4096
DEPTH = 2

HEAD_DIM = 64
A_HEADS = 8
A_BLOCK = 256
A_TOPK = 3
A_QCHUNK = 16
A_WIDTH = A_HEADS * HEAD_DIM
B_GROUPS = 4
B_GROUP_DIM = 128
B_WIDTH = B_GROUPS * B_GROUP_DIM
B_WINDOWS = (2, 4, 8, 16)
C_HEADS = 8
C_KV_HEADS = 2
C_WINDOW = 128
C_WIDTH = C_HEADS * HEAD_DIM
C_KV_WIDTH = C_KV_HEADS * HEAD_DIM
N_BRANCH = 3
BRANCH_WIDTH = 512
SPLITS = (A_WIDTH, A_WIDTH, A_WIDTH, B_WIDTH, C_WIDTH, C_KV_WIDTH, C_KV_WIDTH, N_BRANCH * D_MODEL)
IN_COLS = 5888
REL_BUCKETS = 32
REL_MAX_DIST = 1024
REL_HEADS = A_HEADS + C_HEADS
MEM_LEN = 256
X_HEADS = 4
X_HEAD_DIM = 128
X_WIDTH = X_HEADS * X_HEAD_DIM
D_FF = 3584
N_EXPERTS = 8
TOP_K = 2
MOE_BLOCK = 256
N_DENSE = (DEPTH + 1) // 2
N_MOE = DEPTH // 2
EPS = 1e-6
NEG_INF = -1e30

kernel_name = 'hybrid_moba_pool_swa_moe_block'


def rms_norm(x, g):
    xf = x.astype(jnp.float32)
    y = xf * lax.rsqrt(jnp.mean(xf * xf, axis=-1, keepdims=True) + EPS)
    return (y * g.astype(jnp.float32)).astype(x.dtype)


def rel_bucket(dist):
    n = jnp.maximum(dist, 0)
    max_exact = REL_BUCKETS // 2
    nf = jnp.maximum(n, 1).astype(jnp.float32)
    large = max_exact + (jnp.log(nf / max_exact) / math.log(REL_MAX_DIST / max_exact)
                         * (REL_BUCKETS - max_exact)).astype(jnp.int32)
    large = jnp.minimum(large, REL_BUCKETS - 1)
    return jnp.where(n < max_exact, n, large)


def split_heads(t, n_heads, g=None):
    B, S, _ = t.shape
    t = t.reshape(B, S, n_heads, HEAD_DIM)
    if g is not None:
        t = rms_norm(t, g)
    return t.transpose(0, 2, 1, 3)


def merge_heads(o):
    B, H, S, Dh = o.shape
    return o.transpose(0, 2, 1, 3).reshape(B, S, H * Dh)


def moba_attention(q, k, v, table):
    B, H, S, Dh = q.shape
    S_pad = -(-S // A_BLOCK) * A_BLOCK
    pad = ((0, 0), (0, 0), (0, S_pad - S), (0, 0))
    q, k, v = jnp.pad(q, pad), jnp.pad(k, pad), jnp.pad(v, pad)
    nb = S_pad // A_BLOCK
    n_sel = min(A_TOPK, nb)
    scale = Dh ** -0.5
    kb = k.reshape(B, H, nb, A_BLOCK, Dh)
    vb = v.reshape(B, H, nb, A_BLOCK, Dh)
    kmean = jnp.mean(kb.astype(jnp.float32), axis=3)
    q_blk = jnp.arange(S_pad) // A_BLOCK
    score = jnp.einsum('bhsd,bhnd->bhsn', q.astype(jnp.float32), kmean)
    past = jnp.arange(nb)[None, :] < q_blk[:, None]
    score = jnp.where(past, score, -jnp.inf)
    _, sel = lax.top_k(score, n_sel)
    gather = jax.vmap(jax.vmap(lambda blocks, idx: blocks[idx]))
    head_ids = jnp.arange(H)[None, :, None, None, None]
    offs = jnp.arange(A_BLOCK)

    def chunk(c):
        start = c * A_QCHUNK
        qc = lax.dynamic_slice_in_dim(q, start, A_QCHUNK, axis=2)
        sc = lax.dynamic_slice_in_dim(sel, start, A_QCHUNK, axis=2)
        qpos = start + jnp.arange(A_QCHUNK)
        own = start // A_BLOCK
        valid_sel = jnp.arange(n_sel) < own
        k_sel = gather(kb, sc)
        v_sel = gather(vb, sc)
        kpos_sel = sc[..., None] * A_BLOCK + offs
        lg_sel = jnp.einsum('bhqd,bhqkld->bhqkl', qc, k_sel,
                            preferred_element_type=jnp.float32) * scale
        lg_sel = lg_sel + table[head_ids, rel_bucket(qpos[:, None, None] - kpos_sel)]
        lg_sel = jnp.where(valid_sel[:, None], lg_sel, NEG_INF)
        k_own = lax.dynamic_index_in_dim(kb, own, axis=2, keepdims=False)
        v_own = lax.dynamic_index_in_dim(vb, own, axis=2, keepdims=False)
        dist_own = qpos[:, None] - (own * A_BLOCK + offs)[None, :]
        lg_own = jnp.einsum('bhqd,bhld->bhql', qc, k_own,
                            preferred_element_type=jnp.float32) * scale
        lg_own = lg_own + table[:, rel_bucket(dist_own)][None]
        lg_own = jnp.where(dist_own >= 0, lg_own, NEG_INF)
        logits = jnp.concatenate([lg_sel.reshape(B, H, A_QCHUNK, n_sel * A_BLOCK), lg_own], axis=-1)
        p = jax.nn.softmax(logits, axis=-1).astype(v.dtype)
        p_sel = p[..., :n_sel * A_BLOCK].reshape(B, H, A_QCHUNK, n_sel, A_BLOCK)
        p_own = p[..., n_sel * A_BLOCK:]
        return (jnp.einsum('bhqkl,bhqkld->bhqd', p_sel, v_sel)
                + jnp.einsum('bhql,bhld->bhqd', p_own, v_own))

    outs = lax.map(chunk, jnp.arange(S_pad // A_QCHUNK))
    out = outs.transpose(1, 2, 0, 3, 4).reshape(B, H, S_pad, Dh)[:, :, :S]
    return merge_heads(out)


def pool_mixer(u, pool_w, pool_scale):
    B, S, _ = u.shape
    ug = u.reshape(B, S, B_GROUPS, B_GROUP_DIM)
    cs = jnp.pad(jnp.cumsum(ug.astype(jnp.float32), axis=1), ((0, 0), (1, 0), (0, 0), (0, 0)))
    t = jnp.arange(S)
    win = jnp.array(B_WINDOWS, dtype=jnp.int32)
    lo = jnp.maximum(t[:, None] + 1 - win[None, :], 0)
    lo_vals = jnp.take_along_axis(cs, lo[None, :, :, None], axis=1)
    cnt = (t[:, None] + 1 - lo).astype(jnp.float32)
    pooled = (cs[:, 1:] - lo_vals) / cnt[None, :, :, None] - ug.astype(jnp.float32)
    mixed = jnp.einsum('bsgc,gcd->bsgd', pooled.astype(u.dtype), pool_w)
    return mixed.reshape(B, S, B_WIDTH) * pool_scale


def swa_attention(q, k, v, sinks, table):
    B, Hq, S, Dh = q.shape
    Hkv = k.shape[1]
    G = Hq // Hkv
    W = C_WINDOW
    nblk = S // W
    scale = Dh ** -0.5
    qb = q.reshape(B, Hkv, G, nblk, W, Dh)
    kb = k.reshape(B, Hkv, nblk, W, Dh)
    vb = v.reshape(B, Hkv, nblk, W, Dh)
    shift = ((0, 0), (0, 0), (1, 0), (0, 0), (0, 0))
    kcat = jnp.concatenate([jnp.pad(kb, shift)[:, :, :-1], kb], axis=3)
    vcat = jnp.concatenate([jnp.pad(vb, shift)[:, :, :-1], vb], axis=3)
    logits = jnp.einsum('bkgnqd,bknsd->bkgnqs', qb, kcat,
                        preferred_element_type=jnp.float32) * scale
    qi = jnp.arange(W)
    kj = jnp.arange(2 * W)
    dist = W + qi[:, None] - kj[None, :]
    bias = table[:, rel_bucket(dist)].reshape(Hkv, G, 1, W, 2 * W)
    blk_ok = (jnp.arange(nblk)[:, None, None] > 0) | (kj >= W)[None, None, :]
    mask = ((dist >= 0) & (dist < W))[None] & blk_ok
    logits = jnp.where(mask, logits + bias, NEG_INF)
    sink = sinks.astype(jnp.float32).reshape(1, Hkv, G, 1, 1, 1)
    m = jnp.maximum(jnp.max(logits, axis=-1, keepdims=True), sink)
    p = jnp.exp(logits - m)
    p = (p / (jnp.sum(p, axis=-1, keepdims=True) + jnp.exp(sink - m))).astype(v.dtype)
    out = jnp.einsum('bkgnqs,bknsd->bkgnqd', p, vcat).reshape(B, Hq, S, Dh)
    return merge_heads(out)


def mixer_sublayer(xn, w_in, b_gate, a_q_gain, a_k_gain, pool_w, pool_scale,
                   c_q_gain, c_k_gain, c_sinks, w_branch, w_out, rel_bias):
    B, S, _ = xn.shape
    h = xn @ w_in
    split_at = [int(i) for i in np.cumsum(SPLITS)[:-1]]
    qa, ka, va, ub, qc, kc, vc, gl = jnp.split(h, split_at, axis=-1)
    tab_a = rel_bias[:, :A_HEADS].T
    tab_c = rel_bias[:, A_HEADS:].T
    oa = moba_attention(split_heads(qa, A_HEADS, a_q_gain), split_heads(ka, A_HEADS, a_k_gain),
                        split_heads(va, A_HEADS), tab_a)
    ob = pool_mixer(ub, pool_w, pool_scale)
    oc = swa_attention(split_heads(qc, C_HEADS, c_q_gain), split_heads(kc, C_KV_HEADS, c_k_gain),
                       split_heads(vc, C_KV_HEADS), c_sinks, tab_c)
    gates = jax.nn.sigmoid(gl.reshape(B, S, N_BRANCH, D_MODEL) + b_gate.reshape(N_BRANCH, D_MODEL))
    merged = gates[:, :, 0] * (oa @ w_branch[0])
    merged = merged + gates[:, :, 1] * (ob @ w_branch[1])
    merged = merged + gates[:, :, 2] * (oc @ w_branch[2])
    return merged @ w_out


def cross_attention(xn, memn, w_xq, w_xk, w_xv, q_gain, k_gain, w_xo):
    B, S, _ = xn.shape
    M = memn.shape[1]
    q = rms_norm((xn @ w_xq).reshape(B, S, X_HEADS, X_HEAD_DIM), q_gain)
    k = rms_norm((memn @ w_xk).reshape(B, M, X_HEADS, X_HEAD_DIM), k_gain)
    v = (memn @ w_xv).reshape(B, M, X_HEADS, X_HEAD_DIM)
    logits = jnp.einsum('bshd,bmhd->bhsm', q, k, preferred_element_type=jnp.float32) * X_HEAD_DIM ** -0.5
    p = jax.nn.softmax(logits, axis=-1).astype(v.dtype)
    o = jnp.einsum('bhsm,bmhd->bshd', p, v).reshape(B, S, X_WIDTH)
    return o @ w_xo


def swiglu(x, w1, w3, w2):
    return (jax.nn.silu(x @ w1) * (x @ w3)) @ w2


def moe_ffn(xn, router, w1, w3, w2):
    B, S, D = xn.shape
    N = B * S
    A = N * TOP_K
    xt = xn.reshape(N, D)
    logits = (xt @ router).astype(jnp.float32)
    top_logit, top_e = lax.top_k(logits, TOP_K)
    gate = jax.nn.softmax(top_logit, axis=-1)
    e_flat = top_e.reshape(A)
    g_flat = gate.reshape(A)
    tok_flat = jnp.arange(A, dtype=jnp.int32) // TOP_K
    order = jnp.argsort(e_flat)
    e_sorted = e_flat[order]
    counts = jnp.bincount(e_flat, length=N_EXPERTS)
    start = jnp.cumsum(counts) - counts
    padded = (counts + MOE_BLOCK - 1) // MOE_BLOCK * MOE_BLOCK
    pend = jnp.cumsum(padded)
    pstart = pend - padded
    dest = pstart[e_sorted] + (jnp.arange(A) - start[e_sorted])
    n_blocks = -(-A // MOE_BLOCK) + N_EXPERTS
    P = n_blocks * MOE_BLOCK
    slot_tok = jnp.full((P,), N, dtype=jnp.int32).at[dest].set(tok_flat[order])
    slot_gate = jnp.zeros((P,), jnp.float32).at[dest].set(g_flat[order])
    block_e = jnp.minimum(jnp.searchsorted(pend, jnp.arange(n_blocks) * MOE_BLOCK, side='right'),
                          N_EXPERTS - 1)
    x_pad = jnp.concatenate([xt, jnp.zeros((1, D), xt.dtype)], axis=0)[slot_tok]

    def run_block(args):
        xb, e = args
        return swiglu(xb, w1[e], w3[e], w2[e])

    y = lax.map(run_block, (x_pad.reshape(n_blocks, MOE_BLOCK, D), block_e)).reshape(P, D)
    y = y * slot_gate[:, None].astype(y.dtype)
    out = jax.ops.segment_sum(y, slot_tok, num_segments=N + 1)[:N]
    return out.reshape(B, S, D)


def setup_inputs(seed: int = 0) -> dict:
    key = jax.random.key(seed)
    ks = list(jax.random.split(key, 40))
    cnt = [0]

    def nk():
        cnt[0] += 1
        return ks[cnt[0] - 1]

    def w(shape, fan_in):
        return jax.random.normal(nk(), shape, jnp.float32) * fan_in ** -0.5

    def gain(shape):
        return 1.0 + 0.02 * jax.random.normal(nk(), shape, jnp.float32)

    def small(shape, s):
        return s * jax.random.normal(nk(), shape, jnp.float32)

    return {
        'x': jax.random.normal(nk(), (BATCH, SEQ, D_MODEL), jnp.float32),
        'mem': jax.random.normal(nk(), (BATCH, MEM_LEN, D_MODEL), jnp.float32),
        'rel_bias': small((REL_BUCKETS, REL_HEADS), 0.5),
        'norm_mix': gain((DEPTH, D_MODEL)),
        'w_in': w((DEPTH, D_MODEL, IN_COLS), D_MODEL),
        'b_gate': small((DEPTH, N_BRANCH * D_MODEL), 0.01),
        'a_q_gain': gain((DEPTH, HEAD_DIM)),
        'a_k_gain': gain((DEPTH, HEAD_DIM)),
        'pool_w': w((DEPTH, B_GROUPS, B_GROUP_DIM, B_GROUP_DIM), B_GROUP_DIM),
        'pool_scale': gain((DEPTH, B_WIDTH)),
        'c_q_gain': gain((DEPTH, HEAD_DIM)),
        'c_k_gain': gain((DEPTH, HEAD_DIM)),
        'c_sinks': small((DEPTH, C_HEADS), 0.5),
        'w_branch': w((DEPTH, N_BRANCH, BRANCH_WIDTH, D_MODEL), BRANCH_WIDTH),
        'w_out': w((DEPTH, D_MODEL, D_MODEL), D_MODEL),
        'norm_cross': gain((DEPTH, D_MODEL)),
        'norm_mem': gain((DEPTH, D_MODEL)),
        'w_xq': w((DEPTH, D_MODEL, X_WIDTH), D_MODEL),
        'w_xk': w((DEPTH, D_MODEL, X_WIDTH), D_MODEL),
        'w_xv': w((DEPTH, D_MODEL, X_WIDTH), D_MODEL),
        'x_q_gain': gain((DEPTH, X_HEAD_DIM)),
        'x_k_gain': gain((DEPTH, X_HEAD_DIM)),
        'w_xo': w((DEPTH, X_WIDTH, D_MODEL), X_WIDTH),
        'norm_ffn': gain((DEPTH, D_MODEL)),
        'ffn_w1': w((N_DENSE, D_MODEL, D_FF), D_MODEL),
        'ffn_w3': w((N_DENSE, D_MODEL, D_FF), D_MODEL),
        'ffn_w2': w((N_DENSE, D_FF, D_MODEL), D_FF),
        'router': w((N_MOE, D_MODEL, N_EXPERTS), D_MODEL),
        'moe_w1': w((N_MOE, N_EXPERTS, D_MODEL, D_FF), D_MODEL),
        'moe_w3': w((N_MOE, N_EXPERTS, D_MODEL, D_FF), D_MODEL),
        'moe_w2': w((N_MOE, N_EXPERTS, D_FF, D_MODEL), D_FF),
    }


def reference(x, mem, rel_bias, norm_mix, w_in, b_gate, a_q_gain, a_k_gain, pool_w, pool_scale,
              c_q_gain, c_k_gain, c_sinks, w_branch, w_out, norm_cross, norm_mem, w_xq, w_xk, w_xv,
              x_q_gain, x_k_gain, w_xo, norm_ffn, ffn_w1, ffn_w3, ffn_w2, router, moe_w1, moe_w3, moe_w2):
    for l in range(DEPTH):
        xn = rms_norm(x, norm_mix[l])
        x = x + mixer_sublayer(xn, w_in[l], b_gate[l], a_q_gain[l], a_k_gain[l], pool_w[l], pool_scale[l],
                               c_q_gain[l], c_k_gain[l], c_sinks[l], w_branch[l], w_out[l], rel_bias)
        xn = rms_norm(x, norm_cross[l])
        memn = rms_norm(mem, norm_mem[l])
        x = x + cross_attention(xn, memn, w_xq[l], w_xk[l], w_xv[l], x_q_gain[l], x_k_gain[l], w_xo[l])
        xn = rms_norm(x, norm_ffn[l])
        if l % 2 == 0:
            i = l // 2
            x = x + swiglu(xn, ffn_w1[i], ffn_w3[i], ffn_w2[i])
        else:
            i = l // 2
            x = x + moe_ffn(xn, router[i], moe_w1[i], moe_w3[i], moe_w2[i])
    return x
```

```cpp
#define HYBRID 0
#include <hip/hip_runtime.h>
#include <stdint.h>
#include <math.h>
#include <type_traits>
namespace cfg {
constexpr int D = 1024, B = 8, S = 4096, NTOK = B * S, DEPTH = 2;
constexpr int HD = 64, AH = 8, ABLK = 256, ATOPK = 3, NBLK = S / ABLK;
constexpr int CH = 8, CKV = 2, CW = 128;
constexpr int INC = 5888;
constexpr int OFF_QA = 0, OFF_KA = 512, OFF_VA = 1024, OFF_UB = 1536, OFF_QC = 2048, OFF_KC = 2560, OFF_VC = 2688, OFF_GL = 2816;
constexpr int MEM = 256, XH = 4, XHD = 128, XW = 512;
constexpr int DFF = 3584, NE = 8;
}
namespace fk {
using namespace cfg;
#define LAS __attribute__((address_space(3)))
#define GAS __attribute__((address_space(1)))
typedef unsigned short bf16_t;
typedef short bf16x8 __attribute__((ext_vector_type(8)));
typedef short s16x4 __attribute__((ext_vector_type(4)));
typedef float f32x2 __attribute__((ext_vector_type(2)));
typedef float f32x4 __attribute__((ext_vector_type(4)));
typedef float f32x16 __attribute__((ext_vector_type(16)));
typedef unsigned u32x2 __attribute__((ext_vector_type(2)));
typedef unsigned u32x4 __attribute__((ext_vector_type(4)));
typedef __bf16 bf16x2_t __attribute__((ext_vector_type(2)));
constexpr float EPS = 1e-6f;
constexpr float LOG2E = 1.4426950408889634f;
constexpr float QSCALE64 = 0.125f * LOG2E;
constexpr float QSCALE128 = 0.08838834764831845f * LOG2E;

__device__ __forceinline__ unsigned pk_bf16(float lo, float hi) { f32x2 v = {lo, hi}; bf16x2_t b = __builtin_convertvector(v, bf16x2_t); return __builtin_bit_cast(unsigned, b); }
__device__ __forceinline__ float bf_lo(unsigned w) { return __uint_as_float(w << 16); }
__device__ __forceinline__ float bf_hi(unsigned w) { return __uint_as_float(w & 0xffff0000u); }
__device__ __forceinline__ float bf2f(bf16_t b) { return __uint_as_float(((unsigned)b) << 16); }
__device__ __forceinline__ float wave_sum(float v) {
#pragma unroll
    for (int o = 1; o < 64; o <<= 1) v += __shfl_xor(v, o);
    return v;
}
__device__ __forceinline__ int fresh_lane() {
    unsigned z = 0u; asm volatile("" : "+s"(z));
    return (int)__builtin_amdgcn_mbcnt_hi(~0u, __builtin_amdgcn_mbcnt_lo(~0u, z));
}
__device__ __forceinline__ int fresh_tid(int wave) { return wave * 64 + fresh_lane(); }
__device__ __forceinline__ float fast_exp2(float x) { return __builtin_amdgcn_exp2f(x); }
__device__ __forceinline__ float fast_rcp(float x) { return __builtin_amdgcn_rcpf(x); }
__device__ __forceinline__ float sigmoidf_fast(float x) { return fast_rcp(1.0f + fast_exp2(-x * LOG2E)); }

#define XB_TMO      128
#define XB_XCNT(j)  (256  + 64 * (j))
#define XB_XSUB(j)  (1280 + 64 * (j))
#define XB_XGEN(j)  (2304 + 64 * (j))
#define XB_TOP      3328
#define XB_TOPGEN   3392
#define XCD_BAR_WORDS 3456
#define XB_SPIN_CAP (1u << 18)
__device__ __forceinline__ unsigned xb_ld(unsigned* p)              { return __hip_atomic_load(p, __ATOMIC_RELAXED, __HIP_MEMORY_SCOPE_AGENT); }
__device__ __forceinline__ unsigned xb_add(unsigned* p, unsigned v) { return __hip_atomic_fetch_add(p, v, __ATOMIC_RELAXED, __HIP_MEMORY_SCOPE_AGENT); }
__device__ __forceinline__ unsigned xb_xcc_id() { return (unsigned)__builtin_amdgcn_s_getreg((3 << 11) | 20) & 0xFu; }
#define XB_SPIN(cond, bar) do { unsigned _sp = 0; while (cond) { __builtin_amdgcn_s_sleep(1); \
    if ((++_sp & 255u) == 0u) { if (xb_ld(&(bar)[XB_TMO])) break; if (_sp > XB_SPIN_CAP) { atomicAdd(&(bar)[XB_TMO], 1u); break; } } } } while (0)
struct XcdBarrier { unsigned* bar; unsigned x; volatile LAS unsigned* st; int wave; };
__device__ __forceinline__ XcdBarrier xcd_barrier_post(unsigned* bar, volatile LAS unsigned* st) {
    XcdBarrier b; b.bar = bar; b.x = xb_xcc_id(); b.st = st; b.wave = __builtin_amdgcn_readfirstlane((int)threadIdx.x >> 6);
    if (threadIdx.x == 0) (void)xb_add(&bar[XB_XCNT(b.x)], 1u);
    return b;
}
__device__ __forceinline__ void xcd_barrier_complete(unsigned* bar, unsigned x, unsigned& nloc, unsigned& nx) {
    const unsigned G = gridDim.x * gridDim.y * gridDim.z;
    unsigned sum, cnt, mine, sp = 0u;
    for (;;) {
        sum = 0u; cnt = 0u; mine = 0u;
#pragma unroll
        for (unsigned j = 0; j < 16; ++j) { const unsigned c = xb_ld(&bar[XB_XCNT(j)]); sum += c; cnt += (c > 0u) ? 1u : 0u; mine = (j == x) ? c : mine; }
        if (sum == G) break;
        __builtin_amdgcn_s_sleep(1);
        if ((++sp & 255u) == 0u) { if (xb_ld(&bar[XB_TMO])) break; if (sp > XB_SPIN_CAP) { atomicAdd(&bar[XB_TMO], 1u); break; } }
    }
    nloc = mine > 0u ? mine : 1u; nx = cnt > 0u ? cnt : 1u;
}
__device__ __forceinline__ void xcd_barrier(const XcdBarrier& b) {
    asm volatile("s_waitcnt vmcnt(0)" ::: "memory");
    __syncthreads();
    if (fresh_tid(b.wave) == 0) {
        unsigned* bar = b.bar; asm volatile("" : "+s"(bar));
        __builtin_amdgcn_s_waitcnt(0);
        const unsigned bx = xb_xcc_id();
        unsigned nloc = b.st[0], nx = b.st[1];
        if (nloc == 0u) { xcd_barrier_complete(bar, bx, nloc, nx); b.st[0] = nloc; b.st[1] = nx; }
        const unsigned old = xb_add(&bar[XB_XSUB(bx)], 1u);
        const unsigned gen = old / nloc;
        if (old + 1u == (gen + 1u) * nloc) {
            __builtin_amdgcn_fence(__ATOMIC_RELEASE, "agent");
            asm volatile("s_waitcnt vmcnt(0)" ::: "memory");
            const unsigned og = xb_add(&bar[XB_TOP], 1u);
            const unsigned tg = og / nx;
            if (og + 1u == (tg + 1u) * nx) xb_add(&bar[XB_TOPGEN], 1u);
            else XB_SPIN(xb_ld(&bar[XB_TOPGEN]) == tg, bar);
            __builtin_amdgcn_fence(__ATOMIC_ACQUIRE, "agent");
            xb_add(&bar[XB_XGEN(bx)], 1u);
            asm volatile("s_waitcnt vmcnt(0)" ::: "memory");
        } else {
            XB_SPIN(xb_ld(&bar[XB_XGEN(bx)]) == gen, bar);
            __builtin_amdgcn_fence(__ATOMIC_ACQUIRE, "agent");
            asm volatile("s_waitcnt vmcnt(0)" ::: "memory");
        }
    }
    __syncthreads();
}
}
namespace fk {
namespace pg8 {
constexpr int BM = 256, BK = 64, HALF = 128, HTB = HALF * BK * 2, STAGE_BYTES = 8 * HTB, NXCD = 8;
#ifndef WGM_WIDE
#define WGM_WIDE 4
#endif
#ifndef WGM_NARROW
#define WGM_NARROW 8
#endif
#ifndef WGM_SPLIT
#define WGM_SPLIT 4
#endif
__host__ __device__ __forceinline__ int lds_byte(int r, int c) { const int st = (r >> 4) * 2 + (c >> 5), rr = r & 15, cc = c & 31, ob = rr * 64 + cc * 2; return st * 1024 + (ob ^ (((ob >> 9) & 1) << 5)); }
__host__ __device__ __forceinline__ void stage_rc(int b, int& R, int& C) { const int st = b / 1024, sb = b % 1024, swz = sb ^ (((sb >> 9) & 1) << 5); R = (st >> 1) * 16 + swz / 64; C = (st & 1) * 32 + (swz % 64) / 2; }
__host__ __device__ __forceinline__ int perm32(int rho) { const int n = rho >> 4, i = rho & 15; return 8 * (i >> 2) + 4 * n + (i & 3); }

struct Unit { int pm, pn, sub; const char* a; const char* b; };

__device__ __forceinline__ void tile_order(int L, int nM, int nN, int& pm, int& pn) {
    const int WGM = (nN > WGM_SPLIT) ? WGM_WIDE : WGM_NARROW;
    const int nwg = nM * nN; int wgid = L;
    { const int q = nwg / NXCD, r = nwg % NXCD, xcd = wgid % NXCD, off = wgid / NXCD; wgid = (xcd < r ? xcd * (q + 1) : r * (q + 1) + (xcd - r) * q) + off; }
    const int nig = WGM * nN, gid = wgid / nig, fm = gid * WGM, gsz = (nM - fm) < WGM ? (nM - fm) : WGM;
    pm = fm + ((wgid % nig) % gsz); pn = (wgid % nig) / gsz;
}

template <bool I8, class AccT> __device__ __forceinline__ void mma1(AccT& c, const bf16x8& a, const bf16x8& b) {
    if constexpr (I8) c = __builtin_amdgcn_mfma_i32_16x16x64_i8(__builtin_bit_cast(AccT, a), __builtin_bit_cast(AccT, b), c, 0, 0, 0);
    else c = __builtin_amdgcn_mfma_f32_16x16x32_bf16(a, b, c, 0, 0, 0);
}
typedef int i32x8 __attribute__((ext_vector_type(8)));
__device__ __forceinline__ void mma8(f32x4& c, const bf16x8& a0, const bf16x8& a1, const bf16x8& b0, const bf16x8& b1) {
    typedef int i32x4_ __attribute__((ext_vector_type(4)));
    const i32x8 A = __builtin_shufflevector(__builtin_bit_cast(i32x4_, a0), __builtin_bit_cast(i32x4_, a1), 0, 1, 2, 3, 4, 5, 6, 7), Bv = __builtin_shufflevector(__builtin_bit_cast(i32x4_, b0), __builtin_bit_cast(i32x4_, b1), 0, 1, 2, 3, 4, 5, 6, 7);
    c = __builtin_amdgcn_mfma_scale_f32_16x16x128_f8f6f4(A, Bv, c, 0, 0, 0, 0, 0, 0);
}
typedef int i32x4 __attribute__((ext_vector_type(4)));
template <class Epi, class Sched, bool ALIGN_EPI = true, bool SP2 = true, bool I8 = false, bool F8 = false>
__device__ __forceinline__ void gemm_phase(LAS unsigned char* lds, const int K, const Sched& S, const Epi& E, const int wave) {
    typedef typename std::conditional<I8, i32x4, f32x4>::type acc_t;
    int tid_ = fresh_tid(wave); asm volatile("" : "+v"(tid_));
    const int tid = tid_, wid = __builtin_amdgcn_readfirstlane(tid >> 6), lane = tid & 63, wr = wid >> 2, wc = wid & 3, fr = lane & 15, fq = lane >> 4;
    const int nt = K / BK;
    unsigned voffA, voffB;
    { int R, C; stage_rc(tid * 16, R, C); const int Rb = Epi::PERM ? ((R & ~31) + perm32(R & 31)) : R;
      voffA = (unsigned)(R * K + C) * 2u; voffB = (unsigned)(Rb * K + C) * 2u; }
    const size_t rstep = (size_t)64 * K * 2;
    const size_t kstep = (size_t)(BK * 2);
    const size_t hstep = (size_t)HALF * K * 2;
    const unsigned ldsw = (unsigned)wid * 1024u;
    const int aoff = lds_byte(wr * 64 + fr, fq * 8), boff = lds_byte(wc * 32 + fr, fq * 8);
#define PG8_SA(b, h) (((b) * 2 + (h)) * HTB)
#define PG8_SB(b, h) ((4 + (b) * 2 + (h)) * HTB)
#define PG8_STAGE(bufoff, gbase, voff) do { _Pragma("unroll") for (int _i = 0; _i < 2; ++_i) { const char* gb_ = (const char*)(gbase) + _i * rstep; asm volatile("" : "+s"(gb_));   \
        __builtin_amdgcn_global_load_lds((const unsigned*)(gb_ + (voff)), (LAS unsigned*)(lds + (bufoff) + ldsw + _i * 8192), 16, 0, 0); } } while (0)
#define PG8_LDA(dst, b, h) do { _Pragma("unroll") for (int m = 0; m < 4; ++m) _Pragma("unroll") for (int k = 0; k < 2; ++k) dst[m][k] = *(const LAS bf16x8*)(lds + PG8_SA(b, h) + aoff + m * 2048 + k * 1024); } while (0)
#define PG8_LDB(dst, b, h) do { _Pragma("unroll") for (int n = 0; n < 2; ++n) _Pragma("unroll") for (int k = 0; k < 2; ++k) dst[n][k] = *(const LAS bf16x8*)(lds + PG8_SB(b, h) + boff + n * 2048 + k * 1024); } while (0)
#define PG8_MMA(ai, bj, At, Bt) do { __builtin_amdgcn_s_setprio(1); _Pragma("unroll") for (int m = 0; m < 4; ++m) _Pragma("unroll") for (int n = 0; n < 2; ++n) { \
        if constexpr (F8) mma8(acc[ai][bj][m][n], Bt[n][0], Bt[n][1], At[m][0], At[m][1]); else { _Pragma("unroll") for (int k = 0; k < 2; ++k) mma1<I8>(acc[ai][bj][m][n], Bt[n][k], At[m][k]); } } __builtin_amdgcn_s_setprio(0); } while (0)
#define PG8_WAIT_V(n) asm volatile("s_waitcnt vmcnt(" #n ")" ::: "memory")
#define PG8_WAIT_L(n) asm volatile("s_waitcnt lgkmcnt(" #n ")" ::: "memory")
#define PG8_BAR __builtin_amdgcn_s_barrier()
#define PG8_SCHED __builtin_amdgcn_sched_barrier(0)
    Unit cur, nxt; int ui = 0;
    if (!S.next(0, cur)) return;
    acc_t acc[2][2][4][2];
#pragma unroll
    for (int a = 0; a < 2; ++a)
#pragma unroll
        for (int b = 0; b < 2; ++b)
#pragma unroll
            for (int m = 0; m < 4; ++m)
#pragma unroll
                for (int n = 0; n < 2; ++n) acc[a][b][m][n] = (acc_t){0, 0, 0, 0};
    bf16x8 At[4][2], B0[2][2], B1[2][2];
    const char* cA = cur.a; const char* cB = cur.b;
    if constexpr (SP2) {
        PG8_STAGE(PG8_SB(0, 0), cB, voffB); PG8_STAGE(PG8_SB(0, 1), cB + hstep, voffB); PG8_STAGE(PG8_SA(0, 0), cA, voffA); PG8_STAGE(PG8_SA(0, 1), cA + hstep, voffA);
        if (wr == 1) PG8_BAR;
        PG8_WAIT_V(2); PG8_BAR;
        PG8_STAGE(PG8_SB(1, 0), cB + kstep, voffB); PG8_STAGE(PG8_SA(1, 0), cA + kstep, voffA); PG8_STAGE(PG8_SB(1, 1), cB + hstep + kstep, voffB);
        PG8_WAIT_V(6); PG8_BAR;
    } else {
        PG8_STAGE(PG8_SB(0, 0), cB, voffB); PG8_STAGE(PG8_SA(0, 0), cA, voffA); PG8_STAGE(PG8_SB(0, 1), cB + hstep, voffB); PG8_STAGE(PG8_SA(0, 1), cA + hstep, voffA);
        if (wr == 1) PG8_BAR;
        PG8_WAIT_V(4); PG8_BAR;
        PG8_STAGE(PG8_SB(1, 0), cB + kstep, voffB); PG8_STAGE(PG8_SA(1, 0), cA + kstep, voffA); PG8_STAGE(PG8_SB(1, 1), cB + hstep + kstep, voffB);
        PG8_WAIT_V(6); PG8_BAR;
    }
    for (;;) {
        const bool has_next = S.next(ui + 1, nxt);
        const char* nA = has_next ? nxt.a : cA; const char* nB = has_next ? nxt.b : cB;
        for (int t = 0; t < nt; t += 2) {
            const bool last = (t == nt - 2);
            const char* a1 = cA + (size_t)(t + 1) * kstep;
            const char* a2 = last ? nA : cA + (size_t)(t + 2) * kstep; const char* b2 = last ? nB : cB + (size_t)(t + 2) * kstep;
            const char* a3 = a2 + kstep; const char* b3 = b2 + kstep;
            if constexpr (SP2) {
            PG8_LDB(B0, 0, 0); PG8_LDB(B1, 0, 1); PG8_SCHED; PG8_LDA(At, 0, 0); PG8_STAGE(PG8_SA(1, 1), a1 + hstep, voffA);
            PG8_WAIT_V(8); PG8_WAIT_L(0); PG8_BAR; PG8_MMA(0, 0, At, B0); PG8_MMA(0, 1, At, B1); PG8_BAR; PG8_SCHED;
            PG8_LDA(At, 0, 1); PG8_STAGE(PG8_SB(0, 0), b2, voffB); PG8_STAGE(PG8_SB(0, 1), b2 + hstep, voffB); PG8_STAGE(PG8_SA(0, 0), a2, voffA);
            PG8_WAIT_V(8); PG8_WAIT_L(0); PG8_BAR; PG8_MMA(1, 0, At, B0); PG8_MMA(1, 1, At, B1); PG8_BAR; PG8_SCHED;
            PG8_LDB(B0, 1, 0); PG8_LDB(B1, 1, 1); PG8_SCHED; PG8_LDA(At, 1, 0); PG8_STAGE(PG8_SA(0, 1), a2 + hstep, voffA);
            PG8_WAIT_V(8); PG8_WAIT_L(0); PG8_BAR; PG8_MMA(0, 0, At, B0); PG8_MMA(0, 1, At, B1); PG8_BAR; PG8_SCHED;
            PG8_LDA(At, 1, 1); PG8_STAGE(PG8_SB(1, 0), b3, voffB); PG8_STAGE(PG8_SB(1, 1), b3 + hstep, voffB); PG8_STAGE(PG8_SA(1, 0), a3, voffA);
            PG8_WAIT_V(8); PG8_WAIT_L(0); PG8_BAR; PG8_MMA(1, 0, At, B0); PG8_MMA(1, 1, At, B1); PG8_BAR; PG8_SCHED;
            } else {
            PG8_LDB(B0, 0, 0); PG8_SCHED; PG8_LDA(At, 0, 0); PG8_STAGE(PG8_SA(1, 1), a1 + hstep, voffA);
            PG8_WAIT_L(8); PG8_BAR; PG8_WAIT_L(0); PG8_MMA(0, 0, At, B0); PG8_BAR; PG8_SCHED;
            PG8_LDB(B1, 0, 1); PG8_STAGE(PG8_SB(0, 0), b2, voffB);
            PG8_BAR; PG8_WAIT_L(0); PG8_MMA(0, 1, At, B1); PG8_BAR;
            PG8_LDA(At, 0, 1); PG8_STAGE(PG8_SA(0, 0), a2, voffA);
            PG8_BAR; PG8_WAIT_L(0); PG8_MMA(1, 0, At, B0); PG8_BAR; PG8_SCHED;
            PG8_STAGE(PG8_SB(0, 1), b2 + hstep, voffB);
            PG8_WAIT_V(6); PG8_BAR; PG8_MMA(1, 1, At, B1); PG8_BAR;
            PG8_LDB(B0, 1, 0); PG8_SCHED; PG8_LDA(At, 1, 0); PG8_STAGE(PG8_SA(0, 1), a2 + hstep, voffA);
            PG8_WAIT_L(8); PG8_BAR; PG8_WAIT_L(0); PG8_MMA(0, 0, At, B0); PG8_BAR; PG8_SCHED;
            PG8_LDB(B1, 1, 1); PG8_STAGE(PG8_SB(1, 0), b3, voffB);
            PG8_BAR; PG8_WAIT_L(0); PG8_MMA(0, 1, At, B1); PG8_BAR;
            PG8_LDA(At, 1, 1); PG8_STAGE(PG8_SA(1, 0), a3, voffA);
            PG8_BAR; PG8_WAIT_L(0); PG8_MMA(1, 0, At, B0); PG8_BAR; PG8_SCHED;
            PG8_STAGE(PG8_SB(1, 1), b3 + hstep, voffB);
            PG8_WAIT_V(6); PG8_BAR; PG8_MMA(1, 1, At, B1); PG8_BAR;
            }
        }
        if constexpr (ALIGN_EPI) { if (wr == 0) PG8_BAR; }
        { const int ln_ = fresh_lane();
          E(acc, cur, wr, wc, ln_ & 15, ln_ >> 4); }
        if (!has_next) break;
        if (!(Epi::KEEPS && cur.sub < 2)) {
#pragma unroll
        for (int a = 0; a < 2; ++a)
#pragma unroll
            for (int b = 0; b < 2; ++b)
#pragma unroll
                for (int m = 0; m < 4; ++m)
#pragma unroll
                    for (int n = 0; n < 2; ++n) acc[a][b][m][n] = (acc_t){0, 0, 0, 0};
        }
        cur = nxt; cA = nA; cB = nB; ++ui;
        if constexpr (ALIGN_EPI) { if (wr == 1) PG8_BAR; }
    }
    PG8_WAIT_V(0);
    if constexpr (!ALIGN_EPI) { if (wr == 0) PG8_BAR; }
    PG8_BAR;
#undef PG8_SA
#undef PG8_SB
#undef PG8_STAGE
#undef PG8_LDA
#undef PG8_LDB
#undef PG8_MMA
#undef PG8_WAIT_V
#undef PG8_WAIT_L
#undef PG8_BAR
#undef PG8_SCHED
}
}
}
namespace fk {
constexpr size_t MiB = 1u << 20;
constexpr size_t WS_CTL = 0, CTL_BYTES = 3 * MiB;
constexpr int    CW_BAR = 4096;
constexpr size_t CTL_KMEAN = 256 * 1024;
constexpr size_t CTL_MOE = 800 * 1024;
constexpr size_t CTL_AMAX = 2560 * 1024;
constexpr size_t CTL_SSQ = 1 * MiB;
constexpr size_t WS_MEMB = 3 * MiB;
constexpr size_t WS_KXV = 7 * MiB;
constexpr size_t WS_RSTDM = 15 * MiB;
constexpr size_t WS_LUTA = WS_RSTDM + 16384;
constexpr int    LUTA_N = 1344, LUTA_TOP = 1087;
constexpr size_t WS_LUTC = WS_LUTA + 65536;
constexpr int    LUTC_N = 512, LUTC_TOP = 255;
constexpr size_t WS_TOPE = WS_LUTC + 32768;
constexpr size_t WS_TOPG = WS_TOPE + 262144;
constexpr size_t WS_TOKSLOT = WS_TOPG + 262144;
constexpr size_t WS_SLOTR = WS_TOKSLOT + 262144;
constexpr int    PSLOT = (NTOK * 2 / 256 + NE) * 256;
constexpr size_t WS_CS13 = WS_SLOTR + 278528;
constexpr size_t WS_CS13E = WS_CS13 + 32768;
constexpr size_t WS_RSQ = WS_CS13E + 262144;
constexpr size_t WS_RSQA = WS_RSQ + 131072;
static_assert(WS_RSQA + 131072 <= 17 * MiB, "small region");
constexpr int    AMAX_WIN = 9 * 2 * DFF;
constexpr int    AMAX_GATE = AMAX_WIN + OFF_GL;
constexpr int    AMAX_W2 = AMAX_WIN + 2 * INC;
static_assert(CTL_AMAX + (size_t)(AMAX_W2 + 16) * 4 <= CTL_BYTES, "ctl region");
constexpr size_t WS_WB = 17 * MiB;
constexpr size_t SZ_WIN = (size_t)INC * D * 2, SZ_WBR = (size_t)D * 512 * 2, SZ_WOUT = (size_t)D * D * 2, SZ_WXQ = (size_t)XW * D * 2, SZ_WXKV = (size_t)2 * XW * D * 2, SZ_WXO = (size_t)D * XW * 2;
constexpr size_t SZ_W13 = (size_t)2 * DFF * D  , SZ_W2 = (size_t)D * DFF  , SZ_WG8 = (size_t)3 * D * D  ;
constexpr size_t WB_WIN = WS_WB, WB_WBR = WB_WIN + 2 * SZ_WIN, WB_WOUT = WB_WBR + 6 * SZ_WBR, WB_WXQ = WB_WOUT + 2 * SZ_WOUT, WB_WXKV = WB_WXQ + 2 * SZ_WXQ, WB_WXO = WB_WXKV + 2 * SZ_WXKV,
                 WB_W13 = WB_WXO + 2 * SZ_WXO, WB_W2 = WB_W13 + SZ_W13, WB_WG8 = WB_W2 + SZ_W2, WB_END = WB_WG8 + 2 * SZ_WG8;
static_assert(WB_END <= 79 * MiB, "weights region");
constexpr size_t WS_XB = 79 * MiB;
constexpr size_t WS_AR = 143 * MiB;
constexpr size_t AR_QA = WS_AR, AR_KA = WS_AR + 32 * MiB, AR_VA = WS_AR + 64 * MiB, AR_UB = WS_AR + 96 * MiB, AR_QC = WS_AR + 128 * MiB, AR_KC = WS_AR + 160 * MiB, AR_VC = WS_AR + 168 * MiB,
                 AR_PB = WS_AR + 176 * MiB, AR_G = WS_AR + 208 * MiB, AR_MERGED = AR_KA;
constexpr size_t AR_XQA = WS_AR + 400 * MiB;
constexpr size_t AR_QX = WS_AR, AR_OX = WS_AR + 32 * MiB;
constexpr size_t AR_HFF = WS_AR, AR_XQ = WS_AR + 224 * MiB;
constexpr size_t AR_W13E = WS_AR, AR_W2E = WS_AR + 56 * MiB, AR_XP8 = WS_AR + 112 * MiB, AR_Y = WS_AR + 178 * MiB, AR_HMOE = WS_AR + 310 * MiB, AR_HREM = WS_AR + 422 * MiB;
constexpr int    MOE_CHUNK_RB = 64;
constexpr size_t WS_NEED = WS_AR + 450 * MiB;

struct Params {
    const float* in[31]; float* out; unsigned char* ws; int ph_lo, ph_hi; int src_is_out; int entry_v;
};

struct Sched2D {
    const char* A; const char* Bt; int nM, nN, K, G, c; int base, count;
    __device__ __forceinline__ bool next(int i, pg8::Unit& u) const {
        const long L = (long)i * G + c; if (L >= count) return false;
        pg8::tile_order((int)L + base, nM, nN, u.pm, u.pn); u.sub = 0;
        u.a = A + (size_t)u.pm * 256 * K * 2; u.b = Bt + (size_t)u.pn * 256 * K * 2; return true;
    }
};
struct SchedMerge {
    unsigned char* ws; int l, nM, nN, K, G, c;
    __device__ __forceinline__ bool next(int i, pg8::Unit& u) const {
        const int t = i / 3, sub = i - 3 * t; const long L = (long)t * G + c; if (L >= (long)nM * nN) return false;
        pg8::tile_order((int)L, nM, nN, u.pm, u.pn); u.sub = sub;
        const size_t ao = sub == 0 ? AR_QA : sub == 1 ? AR_PB : AR_QC;
        u.a = (const char*)ws + ao + (size_t)u.pm * 256 * K * 2; u.b = (const char*)ws + WB_WBR + (size_t)(l * 3 + sub) * SZ_WBR + (size_t)u.pn * 256 * K * 2; return true;
    }
};
template <bool UP> struct SchedMoe {
    unsigned char* ws; const LAS int* pend; int rb0, rb1, xrb0, xrb1, G, c, hrem;
    static constexpr int NN = UP ? 2 * DFF / 256 : D / 256;
    __device__ __forceinline__ bool next(int i, pg8::Unit& u) const {
        const int nmain = rb1 - rb0, nrb = nmain + (xrb1 - xrb0); const long L = (long)i * G + c; if (c < 0 || nrb <= 0 || L >= (long)nrb * NN) return false;
        int pm, pn; pg8::tile_order((int)L, nrb, NN, pm, pn); const int rb = pm < nmain ? rb0 + pm : xrb0 + (pm - nmain); u.pm = rb; u.pn = pn;
        int e = 0;
#pragma unroll
        for (int j = 0; j < NE - 1; ++j) e += (rb * 256 >= pend[j]) ? 1 : 0;
        e = __builtin_amdgcn_readfirstlane(e);
        u.sub = e;
        if (UP) { u.a = (const char*)ws + AR_XP8 + (size_t)rb * 256 * D; u.b = (const char*)ws + AR_W13E + (size_t)e * SZ_W13 + (size_t)pn * 256 * D; }
        else    { u.a = (const char*)ws + (hrem ? AR_HREM : AR_HMOE) + (size_t)(rb - rb0) * 256 * DFF; u.b = (const char*)ws + AR_W2E + (size_t)e * SZ_W2 + (size_t)pn * 256 * DFF; }
        return true;
    }
};

typedef unsigned long long u64_t;
__device__ __forceinline__ u64_t* ssq_ptr(unsigned char* ws, int v) { return (u64_t*)(ws + CTL_SSQ) + (size_t)v * NTOK; }
__device__ __forceinline__ u64_t ssq_fix(float ss) { return (u64_t)(ss * 16777216.0f); }
__device__ __forceinline__ float rstd_from_fix(u64_t q) { return __builtin_amdgcn_rsqf((float)q * (1.0f / 16777216.0f) * (1.0f / D) + EPS); }
__device__ __forceinline__ float row_rstd(const u64_t* ssq, int row) { return rstd_from_fix(ssq[row]); }
#define ROW_FENCE() asm volatile("" ::: "memory")
__device__ __forceinline__ u32x4 pack8(const f32x4& a, const f32x4& b) { u32x4 w; w.x = pk_bf16(a[0], a[1]); w.y = pk_bf16(a[2], a[3]); w.z = pk_bf16(b[0], b[1]); w.w = pk_bf16(b[2], b[3]); return w; }
__device__ __forceinline__ void unpack8(const u32x4& w, f32x4& a, f32x4& b) { a = (f32x4){bf_lo(w.x), bf_hi(w.x), bf_lo(w.y), bf_hi(w.y)}; b = (f32x4){bf_lo(w.z), bf_hi(w.z), bf_lo(w.w), bf_hi(w.w)}; }

struct EpiIn {
    static constexpr bool PERM = true, KEEPS = false;
    unsigned char* ws; const Params& P; int l; bool dry, noatom;
    __device__ __forceinline__ void operator()(const pg8::i32x4 (&acc)[2][2][4][2], const pg8::Unit& u, int wr, int wc, int fr, int fq) const {
        const float* rsq = (const float*)(ws + WS_RSQA);
        float sq[2][4];
#pragma unroll
        for (int ai = 0; ai < 2; ++ai)
#pragma unroll
            for (int m = 0; m < 4; ++m) sq[ai][m] = rsq[u.pm * 256 + ai * 128 + wr * 64 + m * 16 + fr];
        f32x4 csc[2][2];
        { const float* cp = (const float*)(ws + CTL_AMAX) + AMAX_WIN + l * INC + u.pn * 256 + wc * 32 + 8 * fq;
#pragma unroll
          for (int bj = 0; bj < 2; ++bj)
#pragma unroll
              for (int n = 0; n < 2; ++n) csc[bj][n] = *(const f32x4*)(cp + 128 * bj + 4 * n) * (1.0f / 127.0f); }
        const int pn = u.pn; const int gc0 = 256 * pn + 64 * wc + 8 * fq;
        int kind; bf16_t* dst; int ld, col0; const float* gain = nullptr;
        if (pn < 2) { kind = 2; dst = (bf16_t*)(ws + AR_QA); ld = 512; col0 = gc0; gain = P.in[6] + l * HD; }
        else if (pn < 4) { kind = 1; dst = (bf16_t*)(ws + AR_KA); ld = 512; col0 = gc0 - 512; gain = P.in[7] + l * HD; }
        else if (pn < 6) { kind = 0; dst = (bf16_t*)(ws + AR_VA); ld = 512; col0 = gc0 - 1024; }
        else if (pn < 8) { kind = 0; dst = (bf16_t*)(ws + AR_UB); ld = 512; col0 = gc0 - 1536; }
        else if (pn < 10) { kind = 2; dst = (bf16_t*)(ws + AR_QC); ld = 512; col0 = gc0 - 2048; gain = P.in[10] + l * HD; }
        else if (pn == 10) { if (wc < 2) { kind = 1; dst = (bf16_t*)(ws + AR_KC); ld = 128; col0 = gc0 - 2560; gain = P.in[11] + l * HD; } else { kind = 0; dst = (bf16_t*)(ws + AR_VC); ld = 128; col0 = gc0 - 2688; } }
        else { kind = 0; dst = (bf16_t*)(ws + AR_VC); ld = 128; col0 = 0; }
        const float* bgate = P.in[5] + l * 3 * D;
        f32x4 gv[2][2];
#pragma unroll
        for (int bj = 0; bj < 2; ++bj)
#pragma unroll
            for (int n = 0; n < 2; ++n) {
                if (kind == 1 || kind == 2) { gv[bj][n] = *(const f32x4*)(gain + 32 * bj + 8 * fq + 4 * n); if (kind == 2) gv[bj][n] *= QSCALE64; }
                else if (kind == 3) gv[bj][n] = *(const f32x4*)(bgate + col0 + 32 * bj + 4 * n);
                else gv[bj][n] = (f32x4){1.f, 1.f, 1.f, 1.f};
            }
        const bool do_kmean = (pn == 2 || pn == 3);
        f32x4 cs[2][2];
#pragma unroll
        for (int bj = 0; bj < 2; ++bj)
#pragma unroll
            for (int n = 0; n < 2; ++n) cs[bj][n] = (f32x4){0.f, 0.f, 0.f, 0.f};
#pragma unroll
        for (int ai = 0; ai < 2; ++ai)
#pragma unroll
            for (int m = 0; m < 4; ++m) {
                const int row = u.pm * 256 + ai * 128 + wr * 64 + m * 16 + fr;
                const float rs = sq[ai][m];
                f32x4 v[2][2];
#pragma unroll
                for (int bj = 0; bj < 2; ++bj)
#pragma unroll
                    for (int n = 0; n < 2; ++n)
#pragma unroll
                        for (int j = 0; j < 4; ++j) v[bj][n][j] = (float)acc[ai][bj][m][n][j] * (rs * csc[bj][n][j]);
                if (kind == 1 || kind == 2) {
                    float ss = 0.f;
#pragma unroll
                    for (int bj = 0; bj < 2; ++bj)
#pragma unroll
                        for (int n = 0; n < 2; ++n) ss += (v[bj][n][0] * v[bj][n][0] + v[bj][n][1] * v[bj][n][1]) + (v[bj][n][2] * v[bj][n][2] + v[bj][n][3] * v[bj][n][3]);
                    ss += __shfl_xor(ss, 16); ss += __shfl_xor(ss, 32);
                    const float hr = __builtin_amdgcn_rsqf(ss * (1.0f / HD) + EPS);
#pragma unroll
                    for (int bj = 0; bj < 2; ++bj)
#pragma unroll
                        for (int n = 0; n < 2; ++n) v[bj][n] = v[bj][n] * hr * gv[bj][n];
                    if (do_kmean) {
#pragma unroll
                        for (int bj = 0; bj < 2; ++bj)
#pragma unroll
                            for (int n = 0; n < 2; ++n) cs[bj][n] += v[bj][n];
                    }
                } else if (kind == 3) {
#pragma unroll
                    for (int bj = 0; bj < 2; ++bj)
#pragma unroll
                        for (int n = 0; n < 2; ++n)
#pragma unroll
                            for (int j = 0; j < 4; ++j) v[bj][n][j] = sigmoidf_fast(v[bj][n][j] + gv[bj][n][j]);
                }
                bf16_t* rowp = dst + (size_t)row * ld + col0;
#pragma unroll
                for (int bj = 0; bj < 2; ++bj) if (!dry) *(u32x4*)(rowp + 32 * bj) = pack8(v[bj][0], v[bj][1]);
                ROW_FENCE();
            }
        if (do_kmean) {
#pragma unroll
            for (int bj = 0; bj < 2; ++bj)
#pragma unroll
                for (int n = 0; n < 2; ++n)
#pragma unroll
                    for (int j = 0; j < 4; ++j) { float s = cs[bj][n][j]; s += __shfl_xor(s, 1); s += __shfl_xor(s, 2); s += __shfl_xor(s, 4); s += __shfl_xor(s, 8); cs[bj][n][j] = s; }
            if (fr == 0 && !dry && !noatom) {
                const int b = u.pm / NBLK, blk = u.pm % NBLK, h = 4 * (pn - 2) + wc;
                float* kp = (float*)(ws + CTL_KMEAN) + (((size_t)(l * B + b) * AH + h) * NBLK + blk) * HD;
#pragma unroll
                for (int bj = 0; bj < 2; ++bj)
#pragma unroll
                    for (int n = 0; n < 2; ++n)
#pragma unroll
                        for (int j = 0; j < 4; ++j) atomicAdd(kp + 32 * bj + 8 * fq + 4 * n + j, cs[bj][n][j] * (1.0f / ABLK));
            }
        }
    }
};

template <bool SC> struct EpiResT {
    static constexpr bool PERM = true, KEEPS = false;
    unsigned char* ws; int v; bool dry;
    __device__ __forceinline__ void operator()(const f32x4 (&acc)[2][2][4][2], const pg8::Unit& u, int wr, int wc, int fr, int fq) const {
        bf16_t* xb = (bf16_t*)(ws + WS_XB); u64_t* ssq = ssq_ptr(ws, v);
        float osc = 1.0f; if constexpr (SC) osc = __uint_as_float(((const unsigned*)(ws + CTL_AMAX))[AMAX_W2]) * (1.0f / 256.0f);
        const int col = u.pn * 256 + wc * 32 + 8 * fq;
#pragma unroll
        for (int ai = 0; ai < 2; ++ai) {
            u32x4 bs[4][2];
#pragma unroll
            for (int m = 0; m < 4; ++m) { const size_t off = (size_t)(u.pm * 256 + ai * 128 + wr * 64 + m * 16 + fr) * D + col;
#pragma unroll
                for (int bj = 0; bj < 2; ++bj) bs[m][bj] = *(const u32x4*)(xb + off + bj * 128); }
            ROW_FENCE();
#pragma unroll
            for (int m = 0; m < 4; ++m) {
                const int row = u.pm * 256 + ai * 128 + wr * 64 + m * 16 + fr; const size_t off = (size_t)row * D + col; float ss = 0.f;
                float rsc = osc; if constexpr (SC) asm volatile("" : "+v"(rsc));
#pragma unroll
                for (int bj = 0; bj < 2; ++bj) { f32x4 b0, b1; unpack8(bs[m][bj], b0, b1); const f32x4 x0 = SC ? b0 + acc[ai][bj][m][0] * rsc : b0 + acc[ai][bj][m][0], x1 = SC ? b1 + acc[ai][bj][m][1] * rsc : b1 + acc[ai][bj][m][1];
                    if (!dry) *(u32x4*)(xb + off + bj * 128) = pack8(x0, x1);
                    ss += ((x0[0] * x0[0] + x0[1] * x0[1]) + (x0[2] * x0[2] + x0[3] * x0[3])) + ((x1[0] * x1[0] + x1[1] * x1[1]) + (x1[2] * x1[2] + x1[3] * x1[3])); }
                ss += __shfl_xor(ss, 16); ss += __shfl_xor(ss, 32);
                if (fq == 0 && !dry) atomicAdd(ssq + row, ssq_fix(ss));
            }
            ROW_FENCE();
        }
    }
};

typedef EpiResT<false> EpiRes;

__device__ __forceinline__ size_t gate_tile_off(int pm, int pg, int wr, int wc, int fr, int fq) { return ((size_t)pm * 12 + pg) * 65536 + (size_t)(wr * 4 + wc) * 1024 + (size_t)(fq * 16 + fr) * 16; }
struct EpiMerge {
    static constexpr bool PERM = true, KEEPS = true;
    unsigned char* ws; bool dry;
    __device__ __forceinline__ void operator()(f32x4 (&acc)[2][2][4][2], const pg8::Unit& u, int wr, int wc, int fr, int fq) const {
        bf16_t* M = (bf16_t*)(ws + AR_MERGED);
        const int col = u.pn * 256 + wc * 32 + 8 * fq; const int sub = u.sub;
        const unsigned char* gpw = ws + AR_G + gate_tile_off(u.pm, sub * 4 + u.pn, wr, wc, fr, fq); const unsigned char* gpn = gpw + 4 * 65536;
#pragma unroll
        for (int ai = 0; ai < 2; ++ai) {
            u32x4 gw[4], gn[4];
#pragma unroll
            for (int m = 0; m < 4; ++m) { gw[m] = *(const u32x4*)(gpw + (ai * 4 + m) * 8192); gn[m] = (sub < 2) ? *(const u32x4*)(gpn + (ai * 4 + m) * 8192) : (u32x4){0xffffffffu, 0xffffffffu, 0xffffffffu, 0xffffffffu}; }
            ROW_FENCE();
#pragma unroll
            for (int m = 0; m < 4; ++m) { const int row = u.pm * 256 + ai * 128 + wr * 64 + m * 16 + fr;
#pragma unroll
                for (int bj = 0; bj < 2; ++bj) {
#pragma unroll
                    for (int n = 0; n < 2; ++n)
#pragma unroll
                        for (int j = 0; j < 4; j += 2) { const unsigned w = gw[m][2 * bj + n] >> (8 * j), q = gn[m][2 * bj + n] >> (8 * j);
                            const f32x2 rw = {(float)(w & 255u), (float)((w >> 8) & 255u)}, rq = {fast_rcp((float)(q & 255u)), fast_rcp((float)((q >> 8) & 255u))};
                            const f32x2 a2 = (f32x2){acc[ai][bj][m][n][j], acc[ai][bj][m][n][j + 1]} * (rw * rq); acc[ai][bj][m][n][j] = a2[0]; acc[ai][bj][m][n][j + 1] = a2[1]; }
                    if (sub == 2 && !dry) *(u32x4*)(M + (size_t)row * D + col + bj * 128) = pack8(acc[ai][bj][m][0], acc[ai][bj][m][1]); } }
            ROW_FENCE();
        }
    }
};

template <int MODE> struct EpiBf {
    static constexpr bool PERM = true, KEEPS = false;
    bf16_t* O; int ld; const void* rsrc; int row_off; bool dry;
    __device__ __forceinline__ void operator()(const f32x4 (&acc)[2][2][4][2], const pg8::Unit& u, int wr, int wc, int fr, int fq) const {
        float rsv[2][4];
#pragma unroll
        for (int ai = 0; ai < 2; ++ai)
#pragma unroll
            for (int m = 0; m < 4; ++m) { const int row = u.pm * 256 + ai * 128 + wr * 64 + m * 16 + fr;
                rsv[ai][m] = MODE == 0 ? row_rstd((const u64_t*)rsrc, row) : MODE == 1 ? ((const float*)rsrc)[row] : 1.0f; }
        float usc = 1.0f; if constexpr (MODE == 3) usc = __uint_as_float(((const unsigned*)rsrc)[u.sub]) * (1.0f / 256.0f);
#pragma unroll
        for (int ai = 0; ai < 2; ++ai)
#pragma unroll
            for (int m = 0; m < 4; ++m) {
                const int row = u.pm * 256 + ai * 128 + wr * 64 + m * 16 + fr;
                float rs = rsv[ai][m];
                if constexpr (MODE == 3) { rs = usc; asm volatile("" : "+v"(rs)); }
                bf16_t* rowp = O + (size_t)(row - row_off) * ld + u.pn * 256 + wc * 32 + 8 * fq;
#pragma unroll
                for (int bj = 0; bj < 2; ++bj) if (!dry) *(u32x4*)(rowp + bj * 128) = pack8(acc[ai][bj][m][0] * rs, acc[ai][bj][m][1] * rs);
                ROW_FENCE();
            }
    }
};

template <int MODE> struct EpiSwiglu {
    static constexpr bool PERM = true, KEEPS = false;
    bf16_t* H; const void* rsrc; int row_off; bool dry; int abl;
    __device__ __forceinline__ void operator()(const f32x4 (&acc)[2][2][4][2], const pg8::Unit& u, int wr, int wc, int fr, int fq) const {
        float rsv[2][4];
#pragma unroll
        for (int ai = 0; ai < 2; ++ai)
#pragma unroll
            for (int m = 0; m < 4; ++m) { const int row = u.pm * 256 + ai * 128 + wr * 64 + m * 16 + fr;
                rsv[ai][m] = (abl == 3) ? 1.0f : (MODE == 0 ? row_rstd((const u64_t*)rsrc, row) : ((const float*)rsrc)[row]); }
#pragma unroll
        for (int ai = 0; ai < 2; ++ai)
#pragma unroll
            for (int m = 0; m < 4; ++m) {
                const int row = u.pm * 256 + ai * 128 + wr * 64 + m * 16 + fr;
                const float rs = rsv[ai][m];
                f32x4 h[2];
                if (abl == 1) { h[0] = acc[ai][0][m][0] * rs; h[1] = acc[ai][1][m][1] * rs; }
                else {
#pragma unroll
                for (int n = 0; n < 2; ++n)
#pragma unroll
                    for (int j = 0; j < 4; ++j) { const float a1 = acc[ai][0][m][n][j] * rs, a3 = acc[ai][1][m][n][j] * rs; h[n][j] = a1 * sigmoidf_fast(a1) * a3; }
                }
                const u32x4 w = pack8(h[0], h[1]);
                if (!dry || abl == 1 || abl == 3) *(u32x4*)(H + (size_t)(row - row_off) * DFF + u.pn * 128 + wc * 32 + 8 * fq) = w;
                if (abl == 2) asm volatile("" :: "v"(w.x), "v"(w.y), "v"(w.z), "v"(w.w));
                ROW_FENCE();
            }
    }
};
struct EpiSwigluI8 {
    static constexpr bool PERM = true, KEEPS = false;
    unsigned char* ws; int moe; int row_off; bool dry; int xrow0;
    __device__ __forceinline__ void operator()(const pg8::i32x4 (&acc)[2][2][4][2], const pg8::Unit& u, int wr, int wc, int fr, int fq) const {
        const bool ext = u.pm * 256 >= xrow0; const int roff = ext ? xrow0 : row_off;
        unsigned char* H = ws + (moe ? (ext ? AR_HREM : AR_HMOE) : AR_HFF)  ; const float* rs = (const float*)(ws + (moe ? WS_SLOTR : WS_RSQ));
        const float* cp = (const float*)(ws + CTL_AMAX) + (moe ? (size_t)(1 + u.sub) * 2 * DFF : 0) + u.pn * 256 + wc * 32 + 8 * fq;
        float rsv[2][4];
#pragma unroll
        for (int ai = 0; ai < 2; ++ai)
#pragma unroll
            for (int m = 0; m < 4; ++m) rsv[ai][m] = rs[u.pm * 256 + ai * 128 + wr * 64 + m * 16 + fr];
        f32x4 c1[2], c3[2];
#pragma unroll
        for (int n = 0; n < 2; ++n) { c1[n] = *(const f32x4*)(cp + 4 * n) * (1.0f / 127.0f); c3[n] = *(const f32x4*)(cp + 128 + 4 * n) * (1.0f / 127.0f); }
#pragma unroll
        for (int ai = 0; ai < 2; ++ai)
#pragma unroll
            for (int m = 0; m < 4; ++m) {
                const int row = u.pm * 256 + ai * 128 + wr * 64 + m * 16 + fr; const float r = rsv[ai][m];
                f32x4 h[2];
#pragma unroll
                for (int n = 0; n < 2; ++n)
#pragma unroll
                    for (int j = 0; j < 4; ++j) { const float a1 = (float)acc[ai][0][m][n][j] * (r * c1[n][j]), a3 = (float)acc[ai][1][m][n][j] * (r * c3[n][j]); h[n][j] = a1 * sigmoidf_fast(a1) * a3; }
                u32x2 w;
#pragma unroll
                for (int n = 0; n < 2; ++n) { int pk = __builtin_amdgcn_cvt_pk_fp8_f32(__builtin_amdgcn_fmed3f(h[n][0], -448.f, 448.f), __builtin_amdgcn_fmed3f(h[n][1], -448.f, 448.f), 0, false);
                    pk = __builtin_amdgcn_cvt_pk_fp8_f32(__builtin_amdgcn_fmed3f(h[n][2], -448.f, 448.f), __builtin_amdgcn_fmed3f(h[n][3], -448.f, 448.f), pk, true); w[n] = (unsigned)pk; }
                if (!dry) *(u32x2*)(H + (size_t)(row - roff) * DFF + u.pn * 128 + wc * 32 + 8 * fq) = w;
                ROW_FENCE();
            }
    }
};
struct EpiGateI8 {
    static constexpr bool PERM = true, KEEPS = false;
    unsigned char* ws; const Params& P; int l; bool dry;
    __device__ __forceinline__ void operator()(const pg8::i32x4 (&acc)[2][2][4][2], const pg8::Unit& u, int wr, int wc, int fr, int fq) const {
        unsigned char* G = ws + AR_G + gate_tile_off(u.pm, u.pn, wr, wc, fr, fq); const float* rs = (const float*)(ws + WS_RSQA);
        const int col0 = u.pn * 256 + wc * 32 + 8 * fq;
        const float* cp = (const float*)(ws + CTL_AMAX) + AMAX_GATE + l * INC + col0; const float* bp = P.in[5] + l * 3 * D + col0;
        float rsv[2][4];
#pragma unroll
        for (int ai = 0; ai < 2; ++ai)
#pragma unroll
            for (int m = 0; m < 4; ++m) rsv[ai][m] = rs[u.pm * 256 + ai * 128 + wr * 64 + m * 16 + fr];
        f32x4 cs[2][2], bg[2][2];
#pragma unroll
        for (int bj = 0; bj < 2; ++bj)
#pragma unroll
            for (int n = 0; n < 2; ++n) { cs[bj][n] = *(const f32x4*)(cp + 128 * bj + 4 * n) * (1.0f / 127.0f); bg[bj][n] = *(const f32x4*)(bp + 128 * bj + 4 * n); }
#pragma unroll
        for (int ai = 0; ai < 2; ++ai)
#pragma unroll
            for (int m = 0; m < 4; ++m) {
                const int row = u.pm * 256 + ai * 128 + wr * 64 + m * 16 + fr; const float r = rsv[ai][m];
                u32x4 gq = {0u, 0u, 0u, 0u};
#pragma unroll
                for (int bj = 0; bj < 2; ++bj)
#pragma unroll
                    for (int n = 0; n < 2; ++n)
#pragma unroll
                        for (int j = 0; j < 4; ++j) gq[2 * bj + n] = __builtin_amdgcn_cvt_pk_u8_f32(fmaxf(__builtin_rintf(sigmoidf_fast((float)acc[ai][bj][m][n][j] * (r * cs[bj][n][j]) + bg[bj][n][j]) * 255.0f), 1.0f), j, gq[2 * bj + n]);
                if (!dry) *(u32x4*)(G + (ai * 4 + m) * 8192) = gq;
                ROW_FENCE();
            }
    }
};
}
namespace fk {
namespace att {
constexpr int L_BUF = 0;
constexpr int L_KMEAN = 65536;
constexpr int L_LUT = 69632;
constexpr int L_WSF = 77824;
constexpr int L_OST = 79872;
constexpr int L_END = L_OST + 8 * 8192;
constexpr float NEG = -1e30f;

__device__ __forceinline__ int crow(int r, int hi) { return (r & 3) + 8 * (r >> 2) + 4 * hi; }
__device__ __forceinline__ void glds16(const bf16_t* g, LAS unsigned char* l) { __builtin_amdgcn_global_load_lds((const unsigned*)g, (LAS unsigned*)l, 16, 0, 0); }
typedef short v4i16_t __attribute__((ext_vector_type(4)));
__device__ __forceinline__ s16x4 vtr(const LAS unsigned char* p) { return __builtin_bit_cast(s16x4, __builtin_amdgcn_ds_read_tr16_b64_v4i16((LAS v4i16_t*)p)); }

template <int DH> __device__ __forceinline__ void stage_tile(LAS unsigned char* slot, const bf16_t* kt, const bf16_t* vt, int pitchK, int pitchV, int wid, int lane) {
#pragma unroll
    for (int i = 0; i < DH / 64; ++i) { const int pc = wid + 8 * i; glds16(kt + (size_t)lane * pitchK + pc * 8, slot + pc * 1024); }
#pragma unroll
    for (int i = 0; i < DH / 64; ++i) { const int pv = wid + 8 * i, dg = pv >> 2, kg = pv & 3; glds16(vt + (size_t)(16 * kg + (lane >> 2)) * pitchV + dg * 32 + (lane & 3) * 8, slot + DH * 128 + pv * 1024); }
}
template <int DH> __device__ __forceinline__ void qkt(f32x16& p0, f32x16& p1, const f32x16& c, const LAS unsigned char* Ks, const bf16x8 (&qr)[DH / 16], int r32, int hi) {
    const LAS unsigned char* kb = Ks + hi * 1024 + r32 * 16;
    bf16x8 kf[DH / 8];
#pragma unroll
    for (int d0 = 0; d0 < DH / 16; ++d0) { kf[2 * d0] = *(const LAS bf16x8*)(kb + d0 * 2048); kf[2 * d0 + 1] = *(const LAS bf16x8*)(kb + d0 * 2048 + 512); }
    __builtin_amdgcn_sched_barrier(0);
    p0 = __builtin_amdgcn_mfma_f32_32x32x16_bf16(kf[0], qr[0], c, 0, 0, 0); p1 = __builtin_amdgcn_mfma_f32_32x32x16_bf16(kf[1], qr[0], c, 0, 0, 0);
#pragma unroll
    for (int d0 = 1; d0 < DH / 16; ++d0) { p0 = __builtin_amdgcn_mfma_f32_32x32x16_bf16(kf[2 * d0], qr[d0], p0, 0, 0, 0); p1 = __builtin_amdgcn_mfma_f32_32x32x16_bf16(kf[2 * d0 + 1], qr[d0], p1, 0, 0, 0); }
}
__device__ __forceinline__ void qkt2(f32x16& a0, f32x16& a1, f32x16& b0, f32x16& b1, const f32x16& c, const LAS unsigned char* KsA, const LAS unsigned char* KsB, const bf16x8 (&qr)[4], int r32, int hi) {
    const LAS unsigned char* ka = KsA + hi * 1024 + r32 * 16; const LAS unsigned char* kbp = KsB + hi * 1024 + r32 * 16;
    bf16x8 kf[16];
#pragma unroll
    for (int d0 = 0; d0 < 4; ++d0) { kf[2 * d0] = *(const LAS bf16x8*)(ka + d0 * 2048); kf[2 * d0 + 1] = *(const LAS bf16x8*)(ka + d0 * 2048 + 512); }
#pragma unroll
    for (int d0 = 0; d0 < 4; ++d0) { kf[8 + 2 * d0] = *(const LAS bf16x8*)(kbp + d0 * 2048); kf[8 + 2 * d0 + 1] = *(const LAS bf16x8*)(kbp + d0 * 2048 + 512); }
    __builtin_amdgcn_sched_barrier(0);
    __builtin_amdgcn_s_setprio(1);
    a0 = __builtin_amdgcn_mfma_f32_32x32x16_bf16(kf[0], qr[0], c, 0, 0, 0); a1 = __builtin_amdgcn_mfma_f32_32x32x16_bf16(kf[1], qr[0], c, 0, 0, 0);
#pragma unroll
    for (int d0 = 1; d0 < 4; ++d0) { a0 = __builtin_amdgcn_mfma_f32_32x32x16_bf16(kf[2 * d0], qr[d0], a0, 0, 0, 0); a1 = __builtin_amdgcn_mfma_f32_32x32x16_bf16(kf[2 * d0 + 1], qr[d0], a1, 0, 0, 0); }
    b0 = __builtin_amdgcn_mfma_f32_32x32x16_bf16(kf[8], qr[0], c, 0, 0, 0); b1 = __builtin_amdgcn_mfma_f32_32x32x16_bf16(kf[9], qr[0], c, 0, 0, 0);
#pragma unroll
    for (int d0 = 1; d0 < 4; ++d0) { b0 = __builtin_amdgcn_mfma_f32_32x32x16_bf16(kf[8 + 2 * d0], qr[d0], b0, 0, 0, 0); b1 = __builtin_amdgcn_mfma_f32_32x32x16_bf16(kf[8 + 2 * d0 + 1], qr[d0], b1, 0, 0, 0); }
    __builtin_amdgcn_s_setprio(0);
}
constexpr float SM_THR = 8.0f;
template <int DH> __device__ __forceinline__ void softmax_pv(f32x16& p0, f32x16& p1, f32x16 (&o)[DH / 32], float& mref, float& l, f32x16& cn, bool first, LAS float* wsf, const LAS unsigned char* Vs, int lane, int r32, int hi, int abl = 0) {
    if (abl != 1) {
    float ra = fmaxf(fmaxf(p0[0], p0[1]), p1[0]), rb = fmaxf(fmaxf(p0[2], p0[3]), p1[1]); ra = fmaxf(fmaxf(ra, p1[2]), p1[3]);
#pragma unroll
    for (int r = 4; r < 16; r += 4) { ra = fmaxf(fmaxf(ra, p0[r]), p0[r + 1]); rb = fmaxf(fmaxf(rb, p0[r + 2]), p0[r + 3]); ra = fmaxf(fmaxf(ra, p1[r]), p1[r + 1]); rb = fmaxf(fmaxf(rb, p1[r + 2]), p1[r + 3]); }
    float rm = fmaxf(ra, rb); rm = fmaxf(rm, __shfl_xor(rm, 32));
    if (first || __any(rm > SM_THR)) {
        const float dl = first ? rm : fmaxf(rm, 0.f); mref += dl;
#pragma unroll
        for (int r = 0; r < 16; ++r) { p0[r] -= dl; p1[r] -= dl; cn[r] -= dl; }
        if (!first) { const float f = fast_exp2(-dl); l *= f;
            if (hi == 0) wsf[r32] = f;
            asm volatile("s_waitcnt lgkmcnt(0)" ::: "memory");
#pragma unroll
            for (int g = 0; g < 4; ++g) { const f32x4 a = *(const LAS f32x4*)(wsf + 8 * g + 4 * hi);
#pragma unroll
                for (int db = 0; db < DH / 32; ++db) { o[db][4 * g + 0] *= a[0]; o[db][4 * g + 1] *= a[1]; o[db][4 * g + 2] *= a[2]; o[db][4 * g + 3] *= a[3]; } }
            asm volatile("" ::: "memory"); }
    }
    float ps0 = 0.f, ps1 = 0.f;
#pragma unroll
    for (int r = 0; r < 16; ++r) { p0[r] = fast_exp2(p0[r]); p1[r] = fast_exp2(p1[r]); ps0 += p0[r]; ps1 += p1[r]; }
    l += ps0 + ps1;
    }
    bf16x8 pa[4];
    { u32x4 w;
      w = (u32x4){pk_bf16(p0[0], p0[1]), pk_bf16(p0[2], p0[3]), pk_bf16(p0[4], p0[5]), pk_bf16(p0[6], p0[7])}; pa[0] = __builtin_bit_cast(bf16x8, w);
      w = (u32x4){pk_bf16(p0[8], p0[9]), pk_bf16(p0[10], p0[11]), pk_bf16(p0[12], p0[13]), pk_bf16(p0[14], p0[15])}; pa[1] = __builtin_bit_cast(bf16x8, w);
      w = (u32x4){pk_bf16(p1[0], p1[1]), pk_bf16(p1[2], p1[3]), pk_bf16(p1[4], p1[5]), pk_bf16(p1[6], p1[7])}; pa[2] = __builtin_bit_cast(bf16x8, w);
      w = (u32x4){pk_bf16(p1[8], p1[9]), pk_bf16(p1[10], p1[11]), pk_bf16(p1[12], p1[13]), pk_bf16(p1[14], p1[15])}; pa[3] = __builtin_bit_cast(bf16x8, w); }
    const LAS unsigned char* vb = Vs + (4 * hi + ((lane & 15) >> 2)) * 64 + ((lane >> 4) & 1) * 32 + (lane & 3) * 8;
    if (abl != 2)
#pragma unroll
    for (int db = 0; db < DH / 32; ++db)
#pragma unroll
        for (int ks = 0; ks < 4; ++ks) {
            const s16x4 lo = vtr(vb + db * 4096 + ks * 1024), hh = vtr(vb + db * 4096 + ks * 1024 + 512);
            const bf16x8 vf = (bf16x8){lo[0], lo[1], lo[2], lo[3], hh[0], hh[1], hh[2], hh[3]};
            o[db] = __builtin_amdgcn_mfma_f32_32x32x16_bf16(pa[ks], vf, o[db], 0, 0, 0);
        }
}
__device__ __forceinline__ void softmax_pv2(f32x16& a0, f32x16& a1, f32x16& b0, f32x16& b1, f32x16 (&o)[2], float& mref, float& l, f32x16& cn, bool first, LAS float* wsf,
                                            const LAS unsigned char* VsA, const LAS unsigned char* VsB, int lane, int r32, int hi) {
    float ra = fmaxf(fmaxf(a0[0], a0[1]), a1[0]), rb = fmaxf(fmaxf(a0[2], a0[3]), a1[1]), rc = fmaxf(fmaxf(b0[0], b0[1]), b1[0]), rd = fmaxf(fmaxf(b0[2], b0[3]), b1[1]);
    ra = fmaxf(fmaxf(ra, a1[2]), a1[3]); rc = fmaxf(fmaxf(rc, b1[2]), b1[3]);
#pragma unroll
    for (int r = 4; r < 16; r += 4) { ra = fmaxf(fmaxf(ra, a0[r]), a0[r + 1]); rb = fmaxf(fmaxf(rb, a0[r + 2]), a0[r + 3]); ra = fmaxf(fmaxf(ra, a1[r]), a1[r + 1]); rb = fmaxf(fmaxf(rb, a1[r + 2]), a1[r + 3]);
                                      rc = fmaxf(fmaxf(rc, b0[r]), b0[r + 1]); rd = fmaxf(fmaxf(rd, b0[r + 2]), b0[r + 3]); rc = fmaxf(fmaxf(rc, b1[r]), b1[r + 1]); rd = fmaxf(fmaxf(rd, b1[r + 2]), b1[r + 3]); }
    float rm = fmaxf(fmaxf(ra, rb), fmaxf(rc, rd)); rm = fmaxf(rm, __shfl_xor(rm, 32));
    if (first || __any(rm > SM_THR)) {
        const float dl = first ? rm : fmaxf(rm, 0.f); mref += dl;
#pragma unroll
        for (int r = 0; r < 16; ++r) { a0[r] -= dl; a1[r] -= dl; b0[r] -= dl; b1[r] -= dl; cn[r] -= dl; }
        if (!first) { const float f = fast_exp2(-dl); l *= f;
            if (hi == 0) wsf[r32] = f;
            asm volatile("s_waitcnt lgkmcnt(0)" ::: "memory");
#pragma unroll
            for (int g = 0; g < 4; ++g) { const f32x4 s = *(const LAS f32x4*)(wsf + 8 * g + 4 * hi);
#pragma unroll
                for (int db = 0; db < 2; ++db) { o[db][4 * g + 0] *= s[0]; o[db][4 * g + 1] *= s[1]; o[db][4 * g + 2] *= s[2]; o[db][4 * g + 3] *= s[3]; } }
            asm volatile("" ::: "memory"); }
    }
    float s0 = 0.f, s1 = 0.f, s2 = 0.f, s3 = 0.f;
#pragma unroll
    for (int r = 0; r < 16; ++r) { a0[r] = fast_exp2(a0[r]); a1[r] = fast_exp2(a1[r]); b0[r] = fast_exp2(b0[r]); b1[r] = fast_exp2(b1[r]); s0 += a0[r]; s1 += a1[r]; s2 += b0[r]; s3 += b1[r]; }
    l += (s0 + s1) + (s2 + s3);
    bf16x8 pa[8];
#define PK8(P, B) __builtin_bit_cast(bf16x8, (u32x4){pk_bf16(P[B], P[B + 1]), pk_bf16(P[B + 2], P[B + 3]), pk_bf16(P[B + 4], P[B + 5]), pk_bf16(P[B + 6], P[B + 7])})
    pa[0] = PK8(a0, 0); pa[1] = PK8(a0, 8); pa[2] = PK8(a1, 0); pa[3] = PK8(a1, 8); pa[4] = PK8(b0, 0); pa[5] = PK8(b0, 8); pa[6] = PK8(b1, 0); pa[7] = PK8(b1, 8);
#undef PK8
    const int voff = (4 * hi + ((lane & 15) >> 2)) * 64 + ((lane >> 4) & 1) * 32 + (lane & 3) * 8;
#pragma unroll
    for (int t = 0; t < 2; ++t) { const LAS unsigned char* vb = (t == 0 ? VsA : VsB) + voff;
        s16x4 lo[8], hh[8];
#pragma unroll
        for (int db = 0; db < 2; ++db)
#pragma unroll
            for (int ks = 0; ks < 4; ++ks) { lo[db * 4 + ks] = vtr(vb + db * 4096 + ks * 1024); hh[db * 4 + ks] = vtr(vb + db * 4096 + ks * 1024 + 512); }
        __builtin_amdgcn_sched_barrier(0);
        __builtin_amdgcn_s_setprio(1);
#pragma unroll
        for (int ks = 0; ks < 4; ++ks)
#pragma unroll
            for (int db = 0; db < 2; ++db) { const int i = db * 4 + ks;
                const bf16x8 vf = (bf16x8){lo[i][0], lo[i][1], lo[i][2], lo[i][3], hh[i][0], hh[i][1], hh[i][2], hh[i][3]};
                o[db] = __builtin_amdgcn_mfma_f32_32x32x16_bf16(pa[4 * t + ks], vf, o[db], 0, 0, 0); }
        __builtin_amdgcn_s_setprio(0); }
}
template <int DH> __device__ __forceinline__ void store_o(const f32x16 (&o)[DH / 32], float linv, LAS float* wsf, LAS unsigned char* ost, bf16_t* orow, int pitchO, int lane, int r32, int hi) {
    if (hi == 0) wsf[32 + r32] = linv;
    asm volatile("s_waitcnt lgkmcnt(0)" ::: "memory");
    LAS bf16_t* stg = (LAS bf16_t*)ost;
#pragma unroll
    for (int g = 0; g < 4; ++g) { const f32x4 a = *(const LAS f32x4*)(wsf + 32 + 8 * g + 4 * hi);
#pragma unroll
        for (int j = 0; j < 4; ++j) { const int row = 8 * g + 4 * hi + j;
#pragma unroll
            for (int db = 0; db < DH / 32; ++db) { const unsigned w = pk_bf16(o[db][4 * g + j] * a[j], 0.f); stg[row * DH + db * 32 + r32] = (bf16_t)(w & 0xffffu); } } }
    asm volatile("s_waitcnt lgkmcnt(0)" ::: "memory");
    constexpr int CPR = DH / 8;
#pragma unroll
    for (int i = 0; i < 32 * CPR / 64; ++i) { const int ci = i * 64 + lane, row = ci / CPR, ch = ci % CPR;
        const u32x4 v = *(const LAS u32x4*)(ost + row * (DH * 2) + ch * 16); *(u32x4*)(orow + (size_t)row * pitchO + ch * 8) = v; }
    asm volatile("s_waitcnt lgkmcnt(0)" ::: "memory");
}

struct MobaArgs { const bf16_t *Q, *K, *V; bf16_t* O; const float* kmean; const float* lut; bool dry; int abl; };
__device__ __forceinline__ void moba_unit(const MobaArgs& A, int b, int h, int qb, LAS unsigned char* lds, int wave) {
    int tid_ = fresh_tid(wave); asm volatile("" : "+v"(tid_));
    const int tid = tid_, lane = tid & 63, r32 = lane & 31, hi = lane >> 5; const int wid = __builtin_amdgcn_readfirstlane(tid >> 6);
    LAS float* kms = (LAS float*)(lds + L_KMEAN); LAS float* lut = (LAS float*)(lds + L_LUT); LAS float* wsf = (LAS float*)(lds + L_WSF) + wid * 64; LAS unsigned char* ost = lds + L_OST + wid * 8192;
    const int q0 = qb * 256; const size_t rowb = (size_t)b * S;
    const bf16_t* Kh = A.K + rowb * 512 + h * HD; const bf16_t* Vh = A.V + rowb * 512 + h * HD;
    __syncthreads();
    for (int i = tid; i < NBLK * HD; i += 512) kms[i] = A.kmean[((size_t)(b * AH + h) * NBLK) * HD + i];
    for (int i = tid; i < LUTA_N; i += 512) lut[i] = A.lut[h * LUTA_N + i];
    stage_tile<64>(lds + L_BUF, Kh + (size_t)q0 * 512, Vh + (size_t)q0 * 512, 512, 512, wid, lane);
    const int qpos = q0 + 32 * wid + r32;
    bf16x8 qr[4];
    { const bf16_t* qp = A.Q + (rowb + qpos) * 512 + h * HD + hi * 8;
#pragma unroll
      for (int d0 = 0; d0 < 4; ++d0) qr[d0] = *(const bf16x8*)(qp + d0 * 16); }
    asm volatile("s_waitcnt vmcnt(0) lgkmcnt(0)" ::: "memory");
    __syncthreads();
    unsigned selmask = 0u;
    if (qb > 0) {
        float sc[NBLK];
#pragma unroll
        for (int n = 0; n < NBLK; ++n) { float a = 0.f;
            if (n < qb) {
#pragma unroll
                for (int d0 = 0; d0 < 4; ++d0) { const f32x4 k0 = *(const LAS f32x4*)(kms + n * HD + d0 * 16 + hi * 8), k1 = *(const LAS f32x4*)(kms + n * HD + d0 * 16 + hi * 8 + 4);
                    const u32x4 qw = __builtin_bit_cast(u32x4, qr[d0]);
                    a += bf_lo(qw.x) * k0[0] + bf_hi(qw.x) * k0[1] + bf_lo(qw.y) * k0[2] + bf_hi(qw.y) * k0[3] + bf_lo(qw.z) * k1[0] + bf_hi(qw.z) * k1[1] + bf_lo(qw.w) * k1[2] + bf_hi(qw.w) * k1[3]; }
                a += __shfl_xor(a, 32);
            }
            sc[n] = a; }
#pragma unroll
        for (int r = 0; r < ATOPK; ++r) {
            if (r < qb) { int best = 0; float bv = -INFINITY; bool have = false;
#pragma unroll
                for (int n = 0; n < NBLK; ++n) { const bool ok = (n < qb) && !((selmask >> n) & 1u) && (!have || sc[n] > bv); if (ok) { best = n; bv = sc[n]; have = true; } }
                selmask |= 1u << best; }
        }
    }
    float mref = 0.f, l = 0.f; f32x16 o[2], cn;
    float zf = 0.f; asm volatile("" : "+v"(zf));
#pragma unroll
    for (int r = 0; r < 16; ++r) { o[0][r] = zf; o[1][r] = zf; cn[r] = zf; }
    const int NP = 2 * (qb + 1); const int qmin = q0 + 32 * wid;
    const float bfar = lut[LUTA_TOP - 1000];
    stage_tile<64>(lds + L_BUF + 16384, Kh + (size_t)(q0 + 64) * 512, Vh + (size_t)(q0 + 64) * 512, 512, 512, wid, lane);
    for (int j = 0; j < NP; ++j) {
        asm volatile("s_waitcnt vmcnt(0)" ::: "memory");
        __syncthreads();
        if (j + 1 < NP) { const int j1 = j + 1; const int kt1 = (j1 < 2) ? q0 + 128 * j1 : 256 * (qb - 1 - ((j1 - 2) >> 1)) + 128 * ((j1 - 2) & 1);
            LAS unsigned char* sl = lds + L_BUF + (j1 & 1) * 32768;
            stage_tile<64>(sl, Kh + (size_t)kt1 * 512, Vh + (size_t)kt1 * 512, 512, 512, wid, lane);
            stage_tile<64>(sl + 16384, Kh + (size_t)(kt1 + 64) * 512, Vh + (size_t)(kt1 + 64) * 512, 512, 512, wid, lane); }
        const bool own = j < 2; const int blk = own ? qb : qb - 1 - ((j - 2) >> 1); const int kt0 = own ? q0 + 128 * j : 256 * blk + 128 * ((j - 2) & 1);
        const bool sel = own || ((selmask >> blk) & 1u);
        const bool skip = (own ? (kt0 > qmin + 31) : !__any(sel)) || A.abl == 5;
        if (!skip) {
            const LAS unsigned char* slot = lds + L_BUF + (j & 1) * 32768;
            const bool near = (qmin - (kt0 + 127) < 790);
            f32x16 a0, a1, b0, b1;
            if (near && __all(sel)) qkt2(a0, a1, b0, b1, cn, slot, slot + 16384, qr, r32, hi);
            else { f32x16 cv; const float badd = near ? 0.f : bfar;
#pragma unroll
                for (int r = 0; r < 16; ++r) cv[r] = sel ? cn[r] + badd : NEG;
                qkt2(a0, a1, b0, b1, cv, slot, slot + 16384, qr, r32, hi); }
            if (near) {
                const LAS float* lp = lut + (LUTA_TOP - qpos + kt0 + 4 * hi);
#pragma unroll
                for (int r = 0; r < 16; ++r) { const int c = (r & 3) + 8 * (r >> 2); a0[r] += lp[c]; a1[r] += lp[c + 32]; b0[r] += lp[c + 64]; b1[r] += lp[c + 96]; }
                if (own && kt0 + 127 > qmin) {
                    const int lim = qpos - kt0 - 4 * hi;
#pragma unroll
                    for (int r = 0; r < 16; ++r) { const int c = (r & 3) + 8 * (r >> 2); if (c > lim) a0[r] = NEG; if (c + 32 > lim) a1[r] = NEG; if (c + 64 > lim) b0[r] = NEG; if (c + 96 > lim) b1[r] = NEG; }
                }
            }
            softmax_pv2(a0, a1, b0, b1, o, mref, l, cn, j == 0, wsf, slot + 8192, slot + 16384 + 8192, lane, r32, hi);
        }
    }
    const float lt = l + __shfl_xor(l, 32);
    if (!A.dry) store_o<64>(o, fast_rcp(lt), wsf, ost, A.O + (rowb + q0 + 32 * wid) * 512 + h * HD, 512, lane, r32, hi);
}

struct SwaArgs { const bf16_t *Q, *K, *V; bf16_t* O; const float* lut; const float* sinks; bool dry; };
__device__ __forceinline__ void swa_unit(const SwaArgs& A, int b, int kv, int qblk, LAS unsigned char* lds, int wave) {
    int tid_ = fresh_tid(wave); asm volatile("" : "+v"(tid_));
    const int tid = tid_, lane = tid & 63, r32 = lane & 31, hi = lane >> 5; const int wid = __builtin_amdgcn_readfirstlane(tid >> 6);
    LAS float* lut = (LAS float*)(lds + L_LUT); LAS float* wsf = (LAS float*)(lds + L_WSF) + wid * 64; LAS unsigned char* ost = lds + L_OST + wid * 8192;
    const int q0 = qblk * 64, g = wid >> 1, qh = kv * (CH / CKV) + g; const size_t rowb = (size_t)b * S;
    const bf16_t* Kh = A.K + rowb * 128 + kv * HD; const bf16_t* Vh = A.V + rowb * 128 + kv * HD;
    __syncthreads();
    for (int i = tid; i < 4 * LUTC_N; i += 512) lut[i] = A.lut[(kv * 4) * LUTC_N + i];
    stage_tile<64>(lds + L_BUF, Kh + (size_t)q0 * 128, Vh + (size_t)q0 * 128, 128, 128, wid, lane);
    const int qpos = q0 + 32 * (wid & 1) + r32;
    bf16x8 qr[4];
    { const bf16_t* qp = A.Q + (rowb + qpos) * 512 + qh * HD + hi * 8;
#pragma unroll
      for (int d0 = 0; d0 < 4; ++d0) qr[d0] = *(const bf16x8*)(qp + d0 * 16); }
    float mref = 0.f, l = 0.f; f32x16 o[2], cn;
    float zf = 0.f; asm volatile("" : "+v"(zf));
#pragma unroll
    for (int r = 0; r < 16; ++r) { o[0][r] = zf; o[1][r] = zf; cn[r] = zf; }
    const int NT = 1 + (qblk < 2 ? qblk : 2);
    const LAS float* lg = lut + g * LUTC_N;
    for (int i = 0; i < NT; ++i) {
        asm volatile("s_waitcnt vmcnt(0) lgkmcnt(0)" ::: "memory");
        __syncthreads();
        if (i + 1 < NT) { const int kt1 = q0 - 64 * (i + 1); stage_tile<64>(lds + L_BUF + ((i + 1) & 1) * 16384, Kh + (size_t)kt1 * 128, Vh + (size_t)kt1 * 128, 128, 128, wid, lane); }
        const int kt0 = q0 - 64 * i;
        const LAS unsigned char* slot = lds + L_BUF + (i & 1) * 16384;
        f32x16 p0, p1; qkt<64>(p0, p1, cn, slot, qr, r32, hi);
        const int d0 = qpos - kt0 - 4 * hi;
        const LAS float* lp = lg + (LUTC_TOP - d0);
#pragma unroll
        for (int r = 0; r < 16; ++r) { const int c = (r & 3) + 8 * (r >> 2);
            const int dd0 = d0 - c, dd1 = d0 - c - 32;
            p0[r] = (dd0 >= 0 && dd0 < CW) ? p0[r] + lp[c] : NEG; p1[r] = (dd1 >= 0 && dd1 < CW) ? p1[r] + lp[c + 32] : NEG; }
        softmax_pv<64>(p0, p1, o, mref, l, cn, i == 0, wsf, slot + 8192, lane, r32, hi);
    }
    const float lt = l + __shfl_xor(l, 32) + fast_exp2(A.sinks[qh] * LOG2E - mref);
    if (!A.dry) store_o<64>(o, fast_rcp(lt), wsf, ost, A.O + (rowb + q0 + 32 * (wid & 1)) * 512 + qh * HD, 512, lane, r32, hi);
}

struct XArgs { const bf16_t* Q; const bf16_t* KV; bf16_t* O; const float* qgain; bool dry; };
__device__ __forceinline__ void xattn_unit(const XArgs& A, int b, int h, int qt, LAS unsigned char* lds, int wave) {
    int tid_ = fresh_tid(wave); asm volatile("" : "+v"(tid_));
    const int tid = tid_, lane = tid & 63, r32 = lane & 31, hi = lane >> 5; const int wid = __builtin_amdgcn_readfirstlane(tid >> 6);
    LAS float* wsf = (LAS float*)(lds + L_WSF) + wid * 64; LAS unsigned char* ost = lds + L_OST + wid * 8192;
    const int q0 = qt * 256; const size_t rowb = (size_t)b * S;
    const bf16_t* Kh = A.KV + (size_t)b * MEM * 1024 + h * XHD; const bf16_t* Vh = Kh + 512;
    __syncthreads();
    stage_tile<128>(lds + L_BUF, Kh, Vh, 1024, 1024, wid, lane);
    const int qpos = q0 + 32 * wid + r32;
    bf16x8 qr[8];
    { const bf16_t* qp = A.Q + (rowb + qpos) * 512 + h * XHD + hi * 8; float qf[8][8]; float ss = 0.f;
#pragma unroll
      for (int d0 = 0; d0 < 8; ++d0) { const u32x4 w = *(const u32x4*)(qp + d0 * 16); f32x4 a, c; unpack8(w, a, c);
#pragma unroll
          for (int j = 0; j < 4; ++j) { qf[d0][j] = a[j]; qf[d0][4 + j] = c[j]; ss += a[j] * a[j] + c[j] * c[j]; } }
      ss += __shfl_xor(ss, 32);
      const float hr = __builtin_amdgcn_rsqf(ss * (1.0f / XHD) + EPS) * QSCALE128;
#pragma unroll
      for (int d0 = 0; d0 < 8; ++d0) { const f32x4 g0 = *(const f32x4*)(A.qgain + d0 * 16 + hi * 8), g1 = *(const f32x4*)(A.qgain + d0 * 16 + hi * 8 + 4);
          u32x4 w; w.x = pk_bf16(qf[d0][0] * hr * g0[0], qf[d0][1] * hr * g0[1]); w.y = pk_bf16(qf[d0][2] * hr * g0[2], qf[d0][3] * hr * g0[3]);
          w.z = pk_bf16(qf[d0][4] * hr * g1[0], qf[d0][5] * hr * g1[1]); w.w = pk_bf16(qf[d0][6] * hr * g1[2], qf[d0][7] * hr * g1[3]); qr[d0] = __builtin_bit_cast(bf16x8, w); } }
    float mref = 0.f, l = 0.f; f32x16 o[4], cn;
    float zf = 0.f; asm volatile("" : "+v"(zf));
#pragma unroll
    for (int r = 0; r < 16; ++r) cn[r] = zf;
#pragma unroll
    for (int db = 0; db < 4; ++db)
#pragma unroll
        for (int r = 0; r < 16; ++r) o[db][r] = zf;
    for (int i = 0; i < 4; ++i) {
        asm volatile("s_waitcnt vmcnt(0) lgkmcnt(0)" ::: "memory");
        __syncthreads();
        if (i + 1 < 4) stage_tile<128>(lds + L_BUF + ((i + 1) & 1) * 32768, Kh + (size_t)(64 * (i + 1)) * 1024, Vh + (size_t)(64 * (i + 1)) * 1024, 1024, 1024, wid, lane);
        const LAS unsigned char* slot = lds + L_BUF + (i & 1) * 32768;
        f32x16 p0, p1; qkt<128>(p0, p1, cn, slot, qr, r32, hi);
        softmax_pv<128>(p0, p1, o, mref, l, cn, i == 0, wsf, slot + 16384, lane, r32, hi);
    }
    const float lt = l + __shfl_xor(l, 32);
    if (!A.dry) store_o<128>(o, fast_rcp(lt), wsf, ost, A.O + (rowb + q0 + 32 * wid) * 512 + h * XHD, 512, lane, r32, hi);
}
}
}
namespace fk {
constexpr int NWAVES = 8, NTHREADS = 512;
constexpr int LDS_BYTES = 147456, MISC_OFF = LDS_BYTES - 128;

__device__ __forceinline__ int rel_bucket(int dist) {
    int n = dist > 0 ? dist : 0;
    if (n < 16) return n;
    int large = 16 + (int)(logf((float)n / 16.0f) / 4.158883083359672f * 16.0f);
    return large < 31 ? large : 31;
}
__device__ __forceinline__ void transpose_item(const float* W, int ldw, int src_col0, int k0, const float* gain, bf16_t* WT, int dst_row0, int Kd, LAS float* scr, int lane, bool dry = false) {
    float tv[32];
#pragma unroll
    for (int i = 0; i < 32; ++i) { const int kk = 2 * i + (lane >> 5); tv[i] = W[(size_t)(k0 + kk) * ldw + src_col0 + (lane & 31)]; }
    if (gain) {
#pragma unroll
        for (int i = 0; i < 32; ++i) tv[i] *= gain[k0 + 2 * i + (lane >> 5)]; }
#pragma unroll
    for (int i = 0; i < 32; ++i) scr[(2 * i + (lane >> 5)) * 33 + (lane & 31)] = tv[i];
    asm volatile("s_waitcnt lgkmcnt(0)" ::: "memory");
    const int c = lane & 7;
#pragma unroll
    for (int j = 0; j < 4; ++j) { const int n = (lane >> 3) + 8 * j; const LAS float* s = scr + (8 * c) * 33 + n;
        u32x4 o; o.x = pk_bf16(s[0 * 33], s[1 * 33]); o.y = pk_bf16(s[2 * 33], s[3 * 33]); o.z = pk_bf16(s[4 * 33], s[5 * 33]); o.w = pk_bf16(s[6 * 33], s[7 * 33]);
        if (!dry) *(u32x4*)(WT + (size_t)(dst_row0 + n) * Kd + k0 + 8 * c) = o; }
    asm volatile("s_waitcnt lgkmcnt(0)" ::: "memory");
}
__device__ __forceinline__ void tj_plain(const float* W, int K, int N, const float* gain, bf16_t* WT, int dst_row_off, LAS float* scr, int item, int lane, bool dry = false) {
    const int nblk = N / 32, kb = item / nblk, nb = item % nblk;
    transpose_item(W, N, nb * 32, kb * 64, gain, WT, dst_row_off + nb * 32, K, scr, lane, dry);
}
__device__ __forceinline__ void tj_win(const float* W, const float* gain, bf16_t* WT, LAS float* scr, int item, int lane) {
    const int nblk = OFF_GL / 32, kb = item / nblk, nb = item % nblk; const int n0 = nb * 32, pn = n0 >> 8, L0 = n0 & 255;
    transpose_item(W, INC, 256 * pn + 64 * ((L0 >> 5) & 3) + 32 * (L0 >> 7), kb * 64, gain, WT, n0, D, scr, lane);
}
__device__ __forceinline__ void tj_w13(const float* W1, const float* W3, const float* gain, bf16_t* WT, LAS float* scr, int item, int lane, bool dry = false) {
    const int nblk = 2 * DFF / 32, kb = item / nblk, nb = item % nblk; const int n0 = nb * 32, t = n0 >> 8, L0 = n0 & 255;
    transpose_item(L0 < 128 ? W1 : W3, DFF, 128 * t + (L0 & 127), kb * 64, gain, WT, n0, D, scr, lane, dry);
}
__device__ __forceinline__ void w13_absmax_item(const float* W1, const float* W3, const float* gain, unsigned* amax, int item, int lane, bool dry = false) {
    const int kq = item & 3, cb = (item >> 2) % (DFF / 64), mat = (item >> 2) / (DFF / 64); const float* W = mat ? W3 : W1; const int j = cb * 64 + lane;
    float am = 0.f;
#pragma unroll 1
    for (int kb = 0; kb < 8; ++kb) { float tv[32];
#pragma unroll
        for (int i = 0; i < 32; ++i) tv[i] = W[(size_t)(kq * 256 + kb * 32 + i) * DFF + j];
#pragma unroll
        for (int i = 0; i < 32; ++i) am = fmaxf(am, fabsf(tv[i] * gain[kq * 256 + kb * 32 + i])); }
    if (!dry) atomicMax(amax + 256 * (j >> 7) + (j & 127) + 128 * mat, __float_as_uint(am));
}
__device__ __forceinline__ void w13_quant_item(const float* W1, const float* W3, const float* gain, const unsigned* amax, unsigned char* WT8, LAS float* scr, int item, int lane, bool dry = false) {
    const int nblk = 2 * DFF / 32, kb = item / nblk, nb = item % nblk; const int n0 = nb * 32, t = n0 >> 8, L0 = n0 & 255; const float* W = L0 < 128 ? W1 : W3; const int col = 128 * t + (L0 & 127) + (lane & 31);
    const float am = __uint_as_float(amax[n0 + (lane & 31)]); const float inv = am > 0.f ? 127.0f / am : 0.f;
    float tv[32];
#pragma unroll
    for (int i = 0; i < 32; ++i) tv[i] = W[(size_t)(kb * 64 + 2 * i + (lane >> 5)) * DFF + col];
#pragma unroll
    for (int i = 0; i < 32; ++i) scr[(2 * i + (lane >> 5)) * 33 + (lane & 31)] = __builtin_rintf(tv[i] * gain[kb * 64 + 2 * i + (lane >> 5)] * inv);
    asm volatile("s_waitcnt lgkmcnt(0)" ::: "memory");
#pragma unroll
    for (int j = 0; j < 2; ++j) { const int idx = lane + 64 * j, n = idx >> 2, c = idx & 3; const LAS float* s = scr + (16 * c) * 33 + n; u32x4 o;
#define Q4(b) (((unsigned)(int)s[(b) * 33] & 255u) | (((unsigned)(int)s[((b) + 1) * 33] & 255u) << 8) | (((unsigned)(int)s[((b) + 2) * 33] & 255u) << 16) | (((unsigned)(int)s[((b) + 3) * 33] & 255u) << 24))
        o.x = Q4(0); o.y = Q4(4); o.z = Q4(8); o.w = Q4(12);
#undef Q4
        if (!dry) *(u32x4*)(WT8 + (size_t)(n0 + n) * D + kb * 64 + 16 * c) = o; }
    asm volatile("s_waitcnt lgkmcnt(0)" ::: "memory");
}
constexpr int I_W2A = (D / 64) * (DFF / 128);
__device__ __forceinline__ void w2_absmax_item(const float* W, unsigned* amax, int item, int lane, bool dry = false) {
    const int cb = item & 15, kq = item >> 4; float am = 0.f;
#pragma unroll 1
    for (int kb = 0; kb < 4; ++kb) { float tv[32];
#pragma unroll
        for (int i = 0; i < 32; ++i) tv[i] = W[(size_t)(kq * 128 + kb * 32 + i) * D + cb * 64 + lane];
#pragma unroll
        for (int i = 0; i < 32; ++i) am = fmaxf(am, fabsf(tv[i])); }
#pragma unroll
    for (int o = 1; o < 64; o <<= 1) am = fmaxf(am, __shfl_xor(am, o));
    if (lane == 0 && !dry) atomicMax(amax, __float_as_uint(am));
}
__device__ __forceinline__ void w2_fp8_item(const float* W, const unsigned* amax, unsigned char* WT8, LAS float* scr, int item, int lane, bool dry = false) {
    const int kb = item >> 5, nb = item & 31, n0 = nb * 32;
    const float am = __uint_as_float(*amax); const float sc = am > 0.f ? 256.0f / am : 0.f;
    float tv[32];
#pragma unroll
    for (int i = 0; i < 32; ++i) tv[i] = W[(size_t)(kb * 64 + 2 * i + (lane >> 5)) * D + n0 + (lane & 31)];
#pragma unroll
    for (int i = 0; i < 32; ++i) scr[(2 * i + (lane >> 5)) * 33 + (lane & 31)] = tv[i] * sc;
    asm volatile("s_waitcnt lgkmcnt(0)" ::: "memory");
#pragma unroll
    for (int j = 0; j < 2; ++j) { const int idx = lane + 64 * j, n = idx >> 2, c = idx & 3; const LAS float* s = scr + (16 * c) * 33 + n; u32x4 o;
#define F4(b) ((unsigned)__builtin_amdgcn_cvt_pk_fp8_f32(s[((b) + 2) * 33], s[((b) + 3) * 33], __builtin_amdgcn_cvt_pk_fp8_f32(s[(b) * 33], s[((b) + 1) * 33], 0, false), true))
        o.x = F4(0); o.y = F4(4); o.z = F4(8); o.w = F4(12);
#undef F4
        if (!dry) *(u32x4*)(WT8 + (size_t)(n0 + n) * DFF + kb * 64 + 16 * c) = o; }
    asm volatile("s_waitcnt lgkmcnt(0)" ::: "memory");
}
__device__ __forceinline__ int win_dest_of_src(int j) { if (j >= OFF_GL) return j; const int s = j & 255; return (j & ~255) + 128 * ((s >> 5) & 1) + 32 * (s >> 6) + (s & 31); }
__device__ __forceinline__ void wg_absmax_item(const float* W, const float* gain, unsigned* amax, int item, int lane) {
    const int kq = item & 3, cb = item >> 2, j = cb * 64 + lane; float am = 0.f;
#pragma unroll 1
    for (int kb = 0; kb < 8; ++kb) { float tv[32];
#pragma unroll
        for (int i = 0; i < 32; ++i) tv[i] = W[(size_t)(kq * 256 + kb * 32 + i) * INC + j];
#pragma unroll
        for (int i = 0; i < 32; ++i) am = fmaxf(am, fabsf(tv[i] * gain[kq * 256 + kb * 32 + i])); }
    atomicMax(amax + win_dest_of_src(j), __float_as_uint(am));
}
__device__ __forceinline__ void wg_quant_item(const float* W, const float* gain, const unsigned* amax, unsigned char* WT8, LAS float* scr, int item, int lane) {
    constexpr int nblk = INC / 32; const int kb = item / nblk, nb = item % nblk, n0 = nb * 32, pn = n0 >> 8, L0 = n0 & 255;
    const int src0 = (n0 < OFF_GL) ? 256 * pn + 64 * ((L0 >> 5) & 3) + 32 * (L0 >> 7) : n0;
    const float am = __uint_as_float(amax[n0 + (lane & 31)]); const float inv = am > 0.f ? 127.0f / am : 0.f;
    float tv[32];
#pragma unroll
    for (int i = 0; i < 32; ++i) tv[i] = W[(size_t)(kb * 64 + 2 * i + (lane >> 5)) * INC + src0 + (lane & 31)];
#pragma unroll
    for (int i = 0; i < 32; ++i) scr[(2 * i + (lane >> 5)) * 33 + (lane & 31)] = __builtin_rintf(tv[i] * gain[kb * 64 + 2 * i + (lane >> 5)] * inv);
    asm volatile("s_waitcnt lgkmcnt(0)" ::: "memory");
#pragma unroll
    for (int j = 0; j < 2; ++j) { const int idx = lane + 64 * j, n = idx >> 2, c = idx & 3; const LAS float* s = scr + (16 * c) * 33 + n; u32x4 o;
#define Q4(b) (((unsigned)(int)s[(b) * 33] & 255u) | (((unsigned)(int)s[((b) + 1) * 33] & 255u) << 8) | (((unsigned)(int)s[((b) + 2) * 33] & 255u) << 16) | (((unsigned)(int)s[((b) + 3) * 33] & 255u) << 24))
        o.x = Q4(0); o.y = Q4(4); o.z = Q4(8); o.w = Q4(12);
#undef Q4
        *(u32x4*)(WT8 + (size_t)(n0 + n) * D + kb * 64 + 16 * c) = o; }
    asm volatile("s_waitcnt lgkmcnt(0)" ::: "memory");
}
__device__ __forceinline__ float quant_row(const bf16_t* xrow, unsigned char* qrow, int lane, bool dry) {
    const u32x4 w0 = ((const u32x4*)xrow)[2 * lane], w1 = ((const u32x4*)xrow)[2 * lane + 1]; f32x4 v[4]; unpack8(w0, v[0], v[1]); unpack8(w1, v[2], v[3]);
    float am = 0.f;
#pragma unroll
    for (int i = 0; i < 4; ++i)
#pragma unroll
        for (int j = 0; j < 4; ++j) am = fmaxf(am, fabsf(v[i][j]));
#pragma unroll
    for (int o = 1; o < 64; o <<= 1) am = fmaxf(am, __shfl_xor(am, o));
    const float sc = am > 0.f ? am * (1.0f / 127.0f) : 1.0f, inv = 1.0f / sc; u32x4 q;
#define Q4(V) (((unsigned)(int)__builtin_rintf(V[0] * inv) & 255u) | (((unsigned)(int)__builtin_rintf(V[1] * inv) & 255u) << 8) | (((unsigned)(int)__builtin_rintf(V[2] * inv) & 255u) << 16) | (((unsigned)(int)__builtin_rintf(V[3] * inv) & 255u) << 24))
    q.x = Q4(v[0]); q.y = Q4(v[1]); q.z = Q4(v[2]); q.w = Q4(v[3]);
#undef Q4
    if (!dry) ((u32x4*)qrow)[lane] = q;
    return sc;
}
__device__ __forceinline__ void quant_pass(const bf16_t* XB, unsigned char* XQ, float* rsq, const u64_t* ssq, int gw, int NGW, int lane, bool dry) {
    for (int r0 = gw; r0 < NTOK; r0 += 4 * NGW) {
        u32x4 w0[4], w1[4]; u64_t sq[4];
#pragma unroll
        for (int k = 0; k < 4; ++k) { const int row = r0 + k * NGW; const int rr = row < NTOK ? row : 0; w0[k] = ((const u32x4*)(XB + (size_t)rr * D))[2 * lane]; w1[k] = ((const u32x4*)(XB + (size_t)rr * D))[2 * lane + 1]; sq[k] = ssq[rr]; }
#pragma unroll
        for (int k = 0; k < 4; ++k) { const int row = r0 + k * NGW; if (row >= NTOK) continue;
            f32x4 v[4]; unpack8(w0[k], v[0], v[1]); unpack8(w1[k], v[2], v[3]);
            float am = 0.f;
#pragma unroll
            for (int i = 0; i < 4; ++i)
#pragma unroll
                for (int j = 0; j < 4; ++j) am = fmaxf(am, fabsf(v[i][j]));
#pragma unroll
            for (int o = 1; o < 64; o <<= 1) am = fmaxf(am, __shfl_xor(am, o));
            const float sc = am > 0.f ? am * (1.0f / 127.0f) : 1.0f, inv = 1.0f / sc; u32x4 q;
#define Q4(V) (((unsigned)(int)__builtin_rintf(V[0] * inv) & 255u) | (((unsigned)(int)__builtin_rintf(V[1] * inv) & 255u) << 8) | (((unsigned)(int)__builtin_rintf(V[2] * inv) & 255u) << 16) | (((unsigned)(int)__builtin_rintf(V[3] * inv) & 255u) << 24))
            q.x = Q4(v[0]); q.y = Q4(v[1]); q.z = Q4(v[2]); q.w = Q4(v[3]);
#undef Q4
            if (!dry) { ((u32x4*)(XQ + (size_t)row * D))[lane] = q; if (lane == 0) rsq[row] = sc * rstd_from_fix(sq[k]); } }
    }
}
__device__ __forceinline__ float row_to_bf16(const float* xrow, bf16_t* orow, int lane) {
    const f32x4* xr = (const f32x4*)xrow + lane; float s = 0.f; u32x2* o8 = (u32x2*)orow + lane;
#pragma unroll
    for (int j = 0; j < 4; ++j) { const f32x4 v = xr[64 * j]; s += (v.x * v.x + v.y * v.y) + (v.z * v.z + v.w * v.w); u32x2 w; w.x = pk_bf16(v.x, v.y); w.y = pk_bf16(v.z, v.w); o8[64 * j] = w; }
    return wave_sum(s);
}
__device__ __forceinline__ void rows4_to_bf16(const float* x, bf16_t* o, unsigned char* xq, int row0, int stride_rows, float (&ss)[4], float (&qs)[4], int lane) {
    f32x4 v[4][4];
#pragma unroll
    for (int r = 0; r < 4; ++r)
#pragma unroll
        for (int j = 0; j < 4; ++j) v[r][j] = (row0 + r * stride_rows < NTOK) ? ((const f32x4*)(x + (size_t)(row0 + r * stride_rows) * D) + lane)[64 * j] : (f32x4){0.f, 0.f, 0.f, 0.f};
#pragma unroll
    for (int r = 0; r < 4; ++r) { float s = 0.f, am = 0.f; const bool ok = row0 + r * stride_rows < NTOK; u32x2* o8 = (u32x2*)(o + (size_t)(row0 + r * stride_rows) * D) + lane;
#pragma unroll
        for (int j = 0; j < 4; ++j) { const f32x4 q = v[r][j]; s += (q.x * q.x + q.y * q.y) + (q.z * q.z + q.w * q.w); am = fmaxf(fmaxf(am, fmaxf(fabsf(q.x), fabsf(q.y))), fmaxf(fabsf(q.z), fabsf(q.w)));
            u32x2 w; w.x = pk_bf16(q.x, q.y); w.y = pk_bf16(q.z, q.w); if (ok) o8[64 * j] = w; }
        ss[r] = wave_sum(s);
#pragma unroll
        for (int of = 1; of < 64; of <<= 1) am = fmaxf(am, __shfl_xor(am, of));
        const float sc = am > 0.f ? am * (1.0f / 127.0f) : 1.0f, inv = 1.0f / sc; qs[r] = sc;
        unsigned* q8 = (unsigned*)(xq + (size_t)(row0 + r * stride_rows) * D) + lane;
#pragma unroll
        for (int j = 0; j < 4; ++j) { const f32x4 q = v[r][j];
            const unsigned w = ((unsigned)(int)__builtin_rintf(q.x * inv) & 255u) | (((unsigned)(int)__builtin_rintf(q.y * inv) & 255u) << 8) | (((unsigned)(int)__builtin_rintf(q.z * inv) & 255u) << 16) | (((unsigned)(int)__builtin_rintf(q.w * inv) & 255u) << 24);
            if (ok) q8[64 * j] = w; } }
}

struct Frame { LAS unsigned char* lds; int tid, lane, wave, G, bid; unsigned char* ws; };

__device__ __forceinline__ void phase_prologue(const Frame& F, const Params& P) {
    LAS float* scr = (LAS float*)(F.lds + F.wave * 16384);
    const int gw = F.bid * NWAVES + F.wave, NGW = F.G * NWAVES, lane = F.lane; unsigned char* ws = F.ws;
    constexpr int I_WIN = 0, I_GA = (INC / 64) * 4, I_BR = (512 / 64) * (D / 32), I_OUT = (D / 64) * (D / 32), I_XQ = (D / 64) * (XW / 32), I_XO = (XW / 64) * (D / 32), I_W13 = 2 * (DFF / 64) * 4  , I_W2 = I_W2A  ;
    constexpr int PER_L = I_WIN + I_GA + 2 * I_BR + I_OUT + I_XQ + 2 * I_XQ + I_XO;
    constexpr int NITEMS = 2 * PER_L + I_W13 + I_W2;
    for (int it = gw; it < NITEMS; it += NGW) {
        int r = it;
        if (r < 2 * PER_L) { const int l = r / PER_L; r -= l * PER_L;
            if (r < I_WIN) { tj_win(P.in[4] + (size_t)l * D * INC, P.in[3] + l * D, (bf16_t*)(ws + WB_WIN + l * SZ_WIN), scr, r, lane); continue; } r -= I_WIN;
            if (r < I_GA) { wg_absmax_item(P.in[4] + (size_t)l * D * INC, P.in[3] + l * D, (unsigned*)(ws + CTL_AMAX) + AMAX_WIN + l * INC, r, lane); continue; } r -= I_GA;
            if (r < I_BR) { tj_plain(P.in[13] + (size_t)(l * 3 + 0) * 512 * D, 512, D, nullptr, (bf16_t*)(ws + WB_WBR + (l * 3 + 0) * SZ_WBR), 0, scr, r, lane); continue; } r -= I_BR;
            if (r < I_BR) { tj_plain(P.in[13] + (size_t)(l * 3 + 2) * 512 * D, 512, D, nullptr, (bf16_t*)(ws + WB_WBR + (l * 3 + 2) * SZ_WBR), 0, scr, r, lane); continue; } r -= I_BR;
            if (r < I_OUT) { tj_plain(P.in[14] + (size_t)l * D * D, D, D, nullptr, (bf16_t*)(ws + WB_WOUT + l * SZ_WOUT), 0, scr, r, lane); continue; } r -= I_OUT;
            if (r < I_XQ) { tj_plain(P.in[17] + (size_t)l * D * XW, D, XW, P.in[15] + l * D, (bf16_t*)(ws + WB_WXQ + l * SZ_WXQ), 0, scr, r, lane); continue; } r -= I_XQ;
            if (r < I_XQ) { tj_plain(P.in[18] + (size_t)l * D * XW, D, XW, P.in[16] + l * D, (bf16_t*)(ws + WB_WXKV + l * SZ_WXKV), 0, scr, r, lane); continue; } r -= I_XQ;
            if (r < I_XQ) { tj_plain(P.in[19] + (size_t)l * D * XW, D, XW, P.in[16] + l * D, (bf16_t*)(ws + WB_WXKV + l * SZ_WXKV), XW, scr, r, lane); continue; } r -= I_XQ;
            tj_plain(P.in[22] + (size_t)l * XW * D, XW, D, nullptr, (bf16_t*)(ws + WB_WXO + l * SZ_WXO), 0, scr, r, lane); continue; }
        r -= 2 * PER_L;
        if (r < I_W13) { w13_absmax_item(P.in[24], P.in[25], P.in[23], (unsigned*)(ws + CTL_AMAX), r, lane); continue; } r -= I_W13;
        w2_absmax_item(P.in[26], (unsigned*)(ws + CTL_AMAX) + AMAX_W2, r, lane);
    }
    __syncthreads();
    { LAS float* Pt = (LAS float*)F.lds;
      LAS float* Bs = Pt + 128 * 128;
      for (int item = F.bid; item < 2 * 4 * 32; item += F.G) { const int nt = item & 31, g = (item >> 5) & 3, l = item >> 7, n0 = nt * 32;
          const float* pw = P.in[8] + (size_t)(l * 4 + g) * 128 * 128; const float* sc = P.in[9] + l * 512 + g * 128; const float* wb = P.in[13] + ((size_t)(l * 3 + 1) * 512 + g * 128) * D + n0;
          for (int i = F.tid; i < 128 * 128; i += NTHREADS) { const int c = i >> 7, d = i & 127; Pt[d * 128 + c] = pw[i] * sc[d]; }
          for (int i = F.tid; i < 128 * 32; i += NTHREADS) { const int d = i >> 5, n = i & 31; Bs[i] = wb[(size_t)d * D + n]; }
          __syncthreads();
          const int n = F.tid & 31, cq = F.tid >> 5; float a[8];
#pragma unroll
          for (int j = 0; j < 8; ++j) a[j] = 0.f;
          for (int d = 0; d < 128; ++d) { const float b = Bs[d * 32 + n]; const f32x4 p0 = *(const LAS f32x4*)(Pt + d * 128 + cq * 8), p1 = *(const LAS f32x4*)(Pt + d * 128 + cq * 8 + 4);
              a[0] += p0[0] * b; a[1] += p0[1] * b; a[2] += p0[2] * b; a[3] += p0[3] * b; a[4] += p1[0] * b; a[5] += p1[1] * b; a[6] += p1[2] * b; a[7] += p1[3] * b; }
          u32x4 w; w.x = pk_bf16(a[0], a[1]); w.y = pk_bf16(a[2], a[3]); w.z = pk_bf16(a[4], a[5]); w.w = pk_bf16(a[6], a[7]);
          *(u32x4*)((bf16_t*)(ws + WB_WBR + (l * 3 + 1) * SZ_WBR) + (size_t)(n0 + n) * 512 + g * 128 + cq * 8) = w;
          __syncthreads(); } }
    { const int gt = F.bid * NTHREADS + F.tid, NGT = F.G * NTHREADS;
      for (int idx = gt; idx < AH * LUTA_N; idx += NGT) { const int h = idx / LUTA_N, i = idx % LUTA_N, dist = LUTA_TOP - i;
          ((float*)(ws + WS_LUTA))[idx] = dist < 0 ? 0.f : P.in[2][rel_bucket(dist) * 16 + h] * LOG2E; }
      for (int idx = gt; idx < CH * LUTC_N; idx += NGT) { const int h = idx / LUTC_N, i = idx % LUTC_N, dist = LUTC_TOP - i;
          ((float*)(ws + WS_LUTC))[idx] = dist < 0 ? 0.f : P.in[2][rel_bucket(dist) * 16 + 8 + h] * LOG2E; } }
    { const float* xsrc = P.src_is_out ? P.out : P.in[0]; bf16_t* XB = (bf16_t*)(ws + WS_XB); u64_t* ssq = ssq_ptr(ws, P.entry_v);
      for (int m = gw; m < NTOK; m += 4 * NGW) { float ss[4], qs[4]; rows4_to_bf16(xsrc, XB, ws + AR_XQA, m, NGW, ss, qs, lane);
          if (lane == 0) {
#pragma unroll
              for (int r = 0; r < 4; ++r) if (m + r * NGW < NTOK) { ssq[m + r * NGW] = ssq_fix(ss[r]); ((float*)(ws + WS_RSQA))[m + r * NGW] = qs[r] * __builtin_amdgcn_rsqf(ss[r] * (1.0f / D) + EPS); } } }
      bf16_t* MB = (bf16_t*)(ws + WS_MEMB); float* rm = (float*)(ws + WS_RSTDM);
      for (int m = gw; m < B * MEM; m += NGW) { const float s = row_to_bf16(P.in[1] + (size_t)m * D, MB + (size_t)m * D, lane); if (lane == 0) rm[m] = __builtin_amdgcn_rsqf(s * (1.0f / D) + EPS); } }
}

template <int WIN> __device__ __forceinline__ void pool_strip(const bf16_t* UB, bf16_t* PB, int t0, int ch, bool dry) {
    const int s0 = t0 & (S - 1);
    u32x4 R[WIN - 1 + 16];
#pragma unroll
    for (int k = 0; k < WIN - 1 + 16; ++k) { const int dt = k - (WIN - 1); R[k] = (s0 + dt >= 0) ? *(const u32x4*)(UB + (size_t)(t0 + dt) * 512 + ch * 8) : (u32x4){0u, 0u, 0u, 0u}; }
    f32x4 a0 = {0.f, 0.f, 0.f, 0.f}, a1 = a0;
#pragma unroll
    for (int k = 0; k < WIN - 1; ++k) { f32x4 x0, x1; unpack8(R[k], x0, x1); a0 += x0; a1 += x1; }
#pragma unroll
    for (int i = 0; i < 16; ++i) { f32x4 x0, x1; unpack8(R[WIN - 1 + i], x0, x1); a0 += x0; a1 += x1;
        const int cnt = (s0 + i + 1 < WIN) ? s0 + i + 1 : WIN; const float inv = 1.0f / (float)cnt;
        if (!dry) *(u32x4*)(PB + (size_t)(t0 + i) * 512 + ch * 8) = pack8(a0 * inv - x0, a1 * inv - x1);
        f32x4 y0, y1; unpack8(R[i], y0, y1); a0 -= y0; a1 -= y1; }
}
__device__ __forceinline__ void phase_pool(const Frame& F, bool dry) {
    const bf16_t* UB = (const bf16_t*)(F.ws + AR_UB); bf16_t* PB = (bf16_t*)(F.ws + AR_PB);
    const int gw = F.bid * NWAVES + F.wave, NGW = F.G * NWAVES, lane = F.lane;
    for (int it = gw; it < 4 * (NTOK / 64); it += NGW) { const int g = it & 3, it4 = it >> 2; const int strip = 4 * it4 + (lane >> 4), ch = 16 * g + (lane & 15), t0 = strip * 16;
        if (g == 0) pool_strip<2>(UB, PB, t0, ch, dry); else if (g == 1) pool_strip<4>(UB, PB, t0, ch, dry); else if (g == 2) pool_strip<8>(UB, PB, t0, ch, dry); else pool_strip<16>(UB, PB, t0, ch, dry); }
}
__device__ __forceinline__ void phase_kxnorm(const Frame& F, const Params& P) {
    const int gw = F.bid * NWAVES + F.wave, NGW = F.G * NWAVES, lane = F.lane;
    for (int it = gw; it < 2 * B * MEM * XH; it += NGW) { const int h = it & 3, row = (it >> 2) & (B * MEM - 1), l = it >> 13;
        bf16_t* p = (bf16_t*)(F.ws + WS_KXV) + ((size_t)l * B * MEM + row) * 1024 + h * XHD + 2 * lane; const unsigned w = *(const unsigned*)p;
        const float a = bf_lo(w), b = bf_hi(w); const float ss = wave_sum(a * a + b * b); const float r = __builtin_amdgcn_rsqf(ss * (1.0f / XHD) + EPS); const float* g = P.in[21] + l * XHD + 2 * lane;
        *(unsigned*)p = pk_bf16(a * r * g[0], b * r * g[1]); }
}

__device__ __forceinline__ void phase_router(const Frame& F, const Params& P, int mi, bool dry) {
    LAS unsigned* lcnt = (LAS unsigned*)(F.lds); LAS unsigned* lbase = lcnt + 8;
    const bf16_t* xb = (const bf16_t*)(F.ws + WS_XB); const u64_t* ssq = ssq_ptr(F.ws, 5); const float* gain = P.in[23] + 1 * D; const float* router = P.in[27] + (size_t)mi * D * NE;
    int* tope = (int*)(F.ws + WS_TOPE); float* topg = (float*)(F.ws + WS_TOPG); int* rank = (int*)(F.ws + WS_TOKSLOT); unsigned* gcnt = (unsigned*)(F.ws + CTL_MOE);
    const int lane = F.lane;
    float rw[16][NE];
#pragma unroll
    for (int q = 0; q < 4; ++q)
#pragma unroll
        for (int i = 0; i < 4; ++i) { const int cc = (q * 64 + lane) * 4 + i; const f32x4 ra = *(const f32x4*)(router + (size_t)cc * NE), rb = *(const f32x4*)(router + (size_t)cc * NE + 4); const float gg = gain[cc];
            rw[q * 4 + i][0] = ra[0] * gg; rw[q * 4 + i][1] = ra[1] * gg; rw[q * 4 + i][2] = ra[2] * gg; rw[q * 4 + i][3] = ra[3] * gg; rw[q * 4 + i][4] = rb[0] * gg; rw[q * 4 + i][5] = rb[1] * gg; rw[q * 4 + i][6] = rb[2] * gg; rw[q * 4 + i][7] = rb[3] * gg; }
    for (int blk = F.bid; blk < NTOK / 128; blk += F.G) {
        const int base = blk * 128;
        __syncthreads();
        if (F.tid < 8) lcnt[F.tid] = 0u;
        __syncthreads();
#pragma unroll 1
        for (int j4 = 0; j4 < 16; j4 += 4) {
            u32x2 xw[4][4]; u64_t sqv[4];
#pragma unroll
            for (int jj = 0; jj < 4; ++jj) { const int tok = base + F.wave * 16 + j4 + jj; sqv[jj] = ssq[tok];
#pragma unroll
                for (int q = 0; q < 4; ++q) xw[jj][q] = *(const u32x2*)(xb + (size_t)tok * D + (q * 64 + lane) * 4); }
#pragma unroll
            for (int jj = 0; jj < 4; ++jj) { const int tok = base + F.wave * 16 + j4 + jj; const float rs = rstd_from_fix(sqv[jj]);
                float lg[NE];
#pragma unroll
                for (int e = 0; e < NE; ++e) lg[e] = 0.f;
#pragma unroll
                for (int q = 0; q < 4; ++q) { const u32x2 w = xw[jj][q]; const float xv[4] = {bf_lo(w.x), bf_hi(w.x), bf_lo(w.y), bf_hi(w.y)};
#pragma unroll
                    for (int i = 0; i < 4; ++i)
#pragma unroll
                        for (int e = 0; e < NE; ++e) lg[e] += xv[i] * rw[q * 4 + i][e]; }
#pragma unroll
                for (int e = 0; e < NE; ++e) lg[e] = wave_sum(lg[e]) * rs;
                int e0 = 0; float v0 = lg[0];
#pragma unroll
                for (int e = 1; e < NE; ++e) if (lg[e] > v0) { e0 = e; v0 = lg[e]; }
                int e1 = -1; float v1 = -INFINITY;
#pragma unroll
                for (int e = 0; e < NE; ++e) if (e != e0 && (e1 < 0 || lg[e] > v1)) { e1 = e; v1 = lg[e]; }
                const float g1 = __expf(v1 - v0), den = 1.f / (1.f + g1);
                if (lane == 0 && !dry) { const unsigned r0 = __hip_atomic_fetch_add(lcnt + e0, 1u, __ATOMIC_RELAXED, __HIP_MEMORY_SCOPE_WORKGROUP), r1 = __hip_atomic_fetch_add(lcnt + e1, 1u, __ATOMIC_RELAXED, __HIP_MEMORY_SCOPE_WORKGROUP);
                    tope[tok * 2] = e0; tope[tok * 2 + 1] = e1; topg[tok * 2] = den; topg[tok * 2 + 1] = g1 * den; rank[tok * 2] = (int)r0; rank[tok * 2 + 1] = (int)r1; } } }
        asm volatile("s_waitcnt vmcnt(0) lgkmcnt(0)" ::: "memory");
        __syncthreads();
        if (F.tid < 8 && !dry) lbase[F.tid] = atomicAdd(gcnt + F.tid, lcnt[F.tid]);
        __syncthreads();
        if (F.tid < 256 && !dry) { const int a = base * 2 + F.tid; rank[a] += (int)lbase[tope[a]]; }
    }
    __syncthreads();
}
__device__ __forceinline__ void phase_moe_weights_a(const Frame& F, const Params& P, int mi, bool dry) {
    const int gw = F.bid * NWAVES + F.wave, NGW = F.G * NWAVES, lane = F.lane; constexpr int I_A = 2 * (DFF / 64) * 4;
    for (int it = gw; it < NE * (I_A + I_W2A); it += NGW) { const int e = it / (I_A + I_W2A), r = it - e * (I_A + I_W2A); const size_t eo = ((size_t)mi * NE + e) * D * DFF;
        if (r < I_A) w13_absmax_item(P.in[28] + eo, P.in[29] + eo, P.in[23] + 1 * D, (unsigned*)(F.ws + CTL_AMAX) + (1 + e) * 2 * DFF, r, lane, dry);
        else w2_absmax_item(P.in[30] + eo, (unsigned*)(F.ws + CTL_AMAX) + AMAX_W2 + 1 + e, r - I_A, lane, dry); }
}
__device__ __forceinline__ void phase_moe_weights_b(const Frame& F, const Params& P, int mi, bool dry) {
    LAS float* scr = (LAS float*)(F.lds + 1024 + F.wave * 16384);
    const int gw = F.bid * NWAVES + F.wave, NGW = F.G * NWAVES, lane = F.lane;
    constexpr int I_W13 = (D / 64) * (2 * DFF / 32), I_W2 = (DFF / 64) * (D / 32), PER_E = I_W13 + I_W2;
    for (int it = gw; it < NE * PER_E; it += NGW) { const int e = it / PER_E; int r = it - e * PER_E; const size_t eo = ((size_t)mi * NE + e) * D * DFF;
        if (r < I_W13) w13_quant_item(P.in[28] + eo, P.in[29] + eo, P.in[23] + 1 * D, (const unsigned*)(F.ws + CTL_AMAX) + (1 + e) * 2 * DFF, F.ws + AR_W13E + (size_t)e * SZ_W13, scr, r, lane, dry);
        else w2_fp8_item(P.in[30] + eo, (const unsigned*)(F.ws + CTL_AMAX) + AMAX_W2 + 1 + e, F.ws + AR_W2E + (size_t)e * SZ_W2, scr, r - I_W13, lane, dry); }
}
__device__ __forceinline__ void phase_dense_w13_b(const Frame& F, const Params& P) {
    LAS float* scr = (LAS float*)(F.lds + F.wave * 16384);
    const int gw = F.bid * NWAVES + F.wave, NGW = F.G * NWAVES, lane = F.lane; constexpr int I_W13 = (D / 64) * (2 * DFF / 32);
    for (int it = gw; it < I_W13; it += NGW) w13_quant_item(P.in[24], P.in[25], P.in[23], (const unsigned*)(F.ws + CTL_AMAX), F.ws + WB_W13, scr, it, lane);
    constexpr int I_W2 = (DFF / 64) * (D / 32);
    for (int it = gw; it < I_W2; it += NGW) w2_fp8_item(P.in[26], (const unsigned*)(F.ws + CTL_AMAX) + AMAX_W2, F.ws + WB_W2, scr, it, lane);
    constexpr int I_GB = (D / 64) * (INC / 32);
    for (int it = gw; it < 2 * I_GB; it += NGW) { const int l = it / I_GB, r = it - l * I_GB;
        wg_quant_item(P.in[4] + (size_t)l * D * INC, P.in[3] + l * D, (const unsigned*)(F.ws + CTL_AMAX) + AMAX_WIN + l * INC, F.ws + WB_WIN + (size_t)l * SZ_WIN, scr, r, lane); }
    __syncthreads();
}
__device__ __forceinline__ void moe_pends(const Frame& F, int (&pend)[NE], int (&pstart)[NE], int (&cnt)[NE]) {
    const unsigned* gcnt = (const unsigned*)(F.ws + CTL_MOE); int acc = 0;
#pragma unroll
    for (int e = 0; e < NE; ++e) { cnt[e] = (int)__hip_atomic_load(gcnt + e, __ATOMIC_RELAXED, __HIP_MEMORY_SCOPE_AGENT); pstart[e] = acc; acc += (cnt[e] + 255) / 256 * 256; pend[e] = acc; }
}
__device__ __forceinline__ void phase_moe_gather(const Frame& F, bool dry) {
    int pend[NE], pstart[NE], cnt[NE]; moe_pends(F, pend, pstart, cnt);
    const int gw = F.bid * NWAVES + F.wave, NGW = F.G * NWAVES, lane = F.lane;
    const int* tope = (const int*)(F.ws + WS_TOPE); int* tokslot = (int*)(F.ws + WS_TOKSLOT); float* slotr = (float*)(F.ws + WS_SLOTR); const u64_t* ssq = ssq_ptr(F.ws, 5);
    const bf16_t* XB = (const bf16_t*)(F.ws + WS_XB); unsigned char* XP8 = F.ws + AR_XP8;
    for (int t0 = gw; t0 < NTOK; t0 += 2 * NGW) {
        u32x4 w0[2], w1[2]; int e[4], rk[4]; u64_t sq[2];
#pragma unroll
        for (int k = 0; k < 2; ++k) { const int tok = t0 + k * NGW; const bool ok = tok < NTOK; const int tk = ok ? tok : 0;
            w0[k] = ((const u32x4*)(XB + (size_t)tk * D))[2 * lane]; w1[k] = ((const u32x4*)(XB + (size_t)tk * D))[2 * lane + 1];
            e[2 * k] = tope[2 * tk]; e[2 * k + 1] = tope[2 * tk + 1]; rk[2 * k] = tokslot[2 * tk]; rk[2 * k + 1] = tokslot[2 * tk + 1]; sq[k] = ssq[tk]; }
#pragma unroll
        for (int k = 0; k < 2; ++k) { const int tok = t0 + k * NGW; if (tok >= NTOK) continue;
            f32x4 v[4]; unpack8(w0[k], v[0], v[1]); unpack8(w1[k], v[2], v[3]);
            float am = 0.f;
#pragma unroll
            for (int i = 0; i < 4; ++i)
#pragma unroll
                for (int j = 0; j < 4; ++j) am = fmaxf(am, fabsf(v[i][j]));
#pragma unroll
            for (int o = 1; o < 64; o <<= 1) am = fmaxf(am, __shfl_xor(am, o));
            const float sc = am > 0.f ? am * (1.0f / 127.0f) : 1.0f, inv = 1.0f / sc; u32x4 q;
#define Q4(V) (((unsigned)(int)__builtin_rintf(V[0] * inv) & 255u) | (((unsigned)(int)__builtin_rintf(V[1] * inv) & 255u) << 8) | (((unsigned)(int)__builtin_rintf(V[2] * inv) & 255u) << 16) | (((unsigned)(int)__builtin_rintf(V[3] * inv) & 255u) << 24))
            q.x = Q4(v[0]); q.y = Q4(v[1]); q.z = Q4(v[2]); q.w = Q4(v[3]);
#undef Q4
            const float rr = rstd_from_fix(sq[k]);
#pragma unroll
            for (int s2 = 0; s2 < 2; ++s2) { const int ee = e[2 * k + s2]; int ps = 0;
#pragma unroll
                for (int j = 0; j < NE; ++j) ps = (ee == j) ? pstart[j] : ps;
                const int slot = ps + rk[2 * k + s2];
                if (!dry) { ((u32x4*)(XP8 + (size_t)slot * D))[lane] = q; if (lane == 0) { tokslot[2 * tok + s2] = slot; slotr[slot] = sc * rr; } } } }
    }
    for (int it = gw; it < NE * 256; it += NGW) { const int e = it >> 8, j = it & 255; int ps = 0, pe = 0, c = 0;
#pragma unroll
        for (int q = 0; q < NE; ++q) { ps = (e == q) ? pstart[q] : ps; pe = (e == q) ? pend[q] : pe; c = (e == q) ? cnt[q] : c; }
        const unsigned zz = (unsigned)F.tid >> 20;
        const int slot = ps + c + j; if (slot < pe && !dry) { ((u32x4*)(XP8 + (size_t)slot * D))[lane] = (u32x4){zz, zz, zz, zz}; if (lane == 0) slotr[slot] = 0.f; } }
}
__device__ __forceinline__ void phase_moe_combine(const Frame& F, const Params& P, bool dry) {
    const int gw = F.bid * NWAVES + F.wave, NGW = F.G * NWAVES, lane = F.lane;
    const int* tokslot = (const int*)(F.ws + WS_TOKSLOT); const float* topg = (const float*)(F.ws + WS_TOPG); const bf16_t* Y = (const bf16_t*)(F.ws + AR_Y); float* out = P.out;
    const bf16_t* XB = (const bf16_t*)(F.ws + WS_XB);
    for (int t0 = gw; t0 < NTOK; t0 += 4 * NGW) {
        int s0[4], s1[4]; float g0[4], g1[4];
#pragma unroll
        for (int k = 0; k < 4; ++k) { const int tok = t0 + k * NGW; const int tk = tok < NTOK ? tok : 0; s0[k] = tokslot[tk * 2]; s1[k] = tokslot[tk * 2 + 1]; g0[k] = topg[tk * 2]; g1[k] = topg[tk * 2 + 1]; }
#pragma unroll
        for (int q = 0; q < 2; ++q) { const int c = (q * 64 + lane) * 8; u32x4 w0[4], w1[4], wx[4];
#pragma unroll
            for (int k = 0; k < 4; ++k) { const int tok = t0 + k * NGW; const int tk = tok < NTOK ? tok : 0; w0[k] = *(const u32x4*)(Y + (size_t)s0[k] * D + c); w1[k] = *(const u32x4*)(Y + (size_t)s1[k] * D + c); wx[k] = *(const u32x4*)(XB + (size_t)tk * D + c); }
#pragma unroll
            for (int k = 0; k < 4; ++k) { const int tok = t0 + k * NGW; if (tok >= NTOK) continue;
                f32x4 a0, a1, b0, b1, x0, x1; unpack8(w0[k], a0, a1); unpack8(w1[k], b0, b1); unpack8(wx[k], x0, x1); f32x4* o = (f32x4*)(out + (size_t)tok * D + c);
                const f32x4 r0 = x0 + a0 * g0[k] + b0 * g1[k], r1 = x1 + a1 * g0[k] + b1 * g1[k]; if (!dry) { o[0] = r0; o[1] = r1; } } } }
}

constexpr int N_PHASES = 20;
__global__ void __launch_bounds__(NTHREADS, 2) mk_fwd(Params P) {
    extern __shared__ __attribute__((aligned(16))) unsigned char lds_raw[];
    Frame F; F.lds = (LAS unsigned char*)lds_raw; F.tid = threadIdx.x; F.lane = F.tid & 63; F.wave = __builtin_amdgcn_readfirstlane(F.tid >> 6); F.G = gridDim.x; F.bid = blockIdx.x; F.ws = P.ws;
    volatile LAS unsigned* MISC = (volatile LAS unsigned*)(F.lds + MISC_OFF);
    if (F.tid < 32) MISC[F.tid] = 0u;
    __syncthreads();
    unsigned* ctl = (unsigned*)(P.ws + WS_CTL);
    XcdBarrier bar = xcd_barrier_post(ctl + CW_BAR, MISC + 8);
    const int lo = P.ph_lo, hi = P.ph_hi; (void)lo; (void)hi; const int G = F.G, c = F.bid;
#define OPAQUE_WS() unsigned char* ws = P.ws; asm volatile("" : "+s"(ws)); F.ws = ws; F.tid = fresh_tid(F.wave); asm volatile("" : "+v"(F.tid)); F.lane = F.tid & 63; int c = F.bid; asm volatile("" : "+s"(c))
#ifdef ONLY
#define PH_EN(j) ((j) == ONLY)
#else
#define PH_EN(j) true
#endif
#if HYBRID == 0
#define IN(k) true
#else
#define IN(k) (lo <= (k) && (k) < hi)
#endif
#define SEAM(k) do { if (IN(k) && IN((k) + 1)) xcd_barrier(bar); } while (0)
#ifndef PROBE_ABL
#define PROBE_ABL 0
#endif
#ifdef PROBE_N
#ifndef PROBE_AFTER
#define PROBE_AFTER 0
#endif
#ifdef PROBE_REAL
#define PROBE_DRY_ 0
#else
#define PROBE_DRY_ 1
#endif
#define REP_BEGIN(k) for (int rep_ = 0, nrep_ = ((k) >= PROBE_LO && (k) < PROBE_HI) ? PROBE_N : 0; rep_ <= nrep_; ++rep_) { const bool rerun = PROBE_AFTER ? (rep_ > 0) : (rep_ < nrep_), dry = rerun && PROBE_DRY_;
#define REP_END(k) if (rep_ < nrep_) xcd_barrier(bar); }
#else
#define REP_BEGIN(k) { constexpr bool dry = false, rerun = false;
#define REP_END(k) }
#endif
#ifndef NO_P0
    if (IN(0)) { REP_BEGIN(0) OPAQUE_WS(); phase_prologue(F, P); (void)dry; REP_END(0) }
#endif
    SEAM(0);
#ifdef PROBE_BARS
    for (int i_ = 0; i_ < PROBE_BARS; ++i_) xcd_barrier(bar);
#endif

#pragma unroll 1
    for (int l = 0; l < DEPTH; ++l) {
        const int pb = 1 + 9 * l;
        if (PH_EN(0) && IN(pb + 0)) { REP_BEGIN(pb + 0) OPAQUE_WS(); int lq = l; asm volatile("" : "+s"(lq));
            if (lq == 0 && !rerun) { phase_dense_w13_b(F, P); xcd_barrier(bar); }
            if (lq > 0) {
                { const int gw = F.bid * NWAVES + F.wave, NGW = F.G * NWAVES; const u64_t* ssq = ssq_ptr(ws, 3 * lq); float* rsq = (float*)(ws + WS_RSQA);
                  quant_pass((const bf16_t*)(ws + WS_XB), ws + AR_XQA, rsq, ssq, gw, NGW, F.lane, dry); }
                xcd_barrier(bar);
            }
            { Sched2D Sg{(const char*)(ws + AR_XQA), (const char*)(ws + WB_WIN + lq * SZ_WIN), NTOK / 256, OFF_GL / 256, D / 2, G, c, 0, (NTOK / 256) * (OFF_GL / 256)};
              EpiIn E{ws, P, lq, dry, rerun};
              pg8::gemm_phase<EpiIn, Sched2D, true, true, true>(F.lds, D / 2, Sg, E, F.wave); }
            { Sched2D Sg{(const char*)(ws + AR_XQA), (const char*)(ws + WB_WIN + lq * SZ_WIN + (size_t)OFF_GL * D), NTOK / 256, 3 * D / 256, D / 2, G, c, 0, (NTOK / 256) * (3 * D / 256)};
              EpiGateI8 E{ws, P, lq, dry};
              pg8::gemm_phase<EpiGateI8, Sched2D, true, true, true>(F.lds, D / 2, Sg, E, F.wave); }
            if (lq == 0) {
                int c2 = c - 128; asm volatile("" : "+s"(c2));
                if (c2 >= 0 && c2 < 64) { const int l2 = c2 >> 5;
                    Sched2D S2{(const char*)(ws + WS_MEMB), (const char*)(ws + WB_WXKV + l2 * SZ_WXKV), B * MEM / 256, 4, D, 32, c2 & 31, 0, 32};
                    EpiBf<1> E2{(bf16_t*)(ws + WS_KXV) + (size_t)l2 * B * MEM * 1024, 1024, (const float*)(ws + WS_RSTDM), 0, dry};
                    pg8::gemm_phase<EpiBf<1>, Sched2D>(F.lds, D, S2, E2, F.wave); }
            }
        REP_END(pb + 0) }
        SEAM(pb + 0);
        if (PH_EN(1) && IN(pb + 1)) { REP_BEGIN(pb + 1) OPAQUE_WS(); int lq = l; asm volatile("" : "+s"(lq));
#ifndef NO_A2
#ifndef PROBE_SUB
#define PROBE_SUB 0
#endif
#ifndef PROBE_ABL
#define PROBE_ABL 0
#endif
            if (!dry || PROBE_SUB == 0 || PROBE_SUB == 3) phase_pool(F, dry);
            if (lq == 0 && !dry) phase_kxnorm(F, P);
            if (!dry || PROBE_SUB == 0 || PROBE_SUB == 1) { att::MobaArgs A{(const bf16_t*)(ws + AR_QA), (const bf16_t*)(ws + AR_KA), (const bf16_t*)(ws + AR_VA), (bf16_t*)(ws + AR_QA), (const float*)(ws + CTL_KMEAN) + (size_t)lq * B * AH * NBLK * HD, (const float*)(ws + WS_LUTA), dry, dry ? PROBE_ABL : 0};
              for (int pi = c; pi < B * AH * 8; pi += G) { const int bh = pi >> 3, s = pi & 7;
                  att::moba_unit(A, bh / AH, bh % AH, 15 - s, F.lds, F.wave); att::moba_unit(A, bh / AH, bh % AH, s, F.lds, F.wave); } }
            if (!dry || PROBE_SUB == 0 || PROBE_SUB == 2) { att::SwaArgs A{(const bf16_t*)(ws + AR_QC), (const bf16_t*)(ws + AR_KC), (const bf16_t*)(ws + AR_VC), (bf16_t*)(ws + AR_QC), (const float*)(ws + WS_LUTC), P.in[12] + lq * CH, dry};
              for (int u = c; u < B * CKV * (S / 64); u += G) { const int qblk = u & 63, kv = (u >> 6) & 1, b = u >> 7; att::swa_unit(A, b, kv, qblk, F.lds, F.wave); } }
            __syncthreads();
#endif
        REP_END(pb + 1) }
        SEAM(pb + 1);
        if (PH_EN(2) && IN(pb + 2)) { REP_BEGIN(pb + 2) OPAQUE_WS(); int lq = l; asm volatile("" : "+s"(lq));
            SchedMerge Sg{ws, lq, NTOK / 256, D / 256, 512, G, c};
            EpiMerge E{ws, dry};
            pg8::gemm_phase<EpiMerge, SchedMerge>(F.lds, 512, Sg, E, F.wave);
        REP_END(pb + 2) }
        SEAM(pb + 2);
        if (PH_EN(3) && IN(pb + 3)) { REP_BEGIN(pb + 3) OPAQUE_WS(); int lq = l; asm volatile("" : "+s"(lq));
            Sched2D Sg{(const char*)(ws + AR_MERGED), (const char*)(ws + WB_WOUT + lq * SZ_WOUT), NTOK / 256, D / 256, D, G, c, 0, (NTOK / 256) * (D / 256)};
            EpiRes E{ws, 3 * lq + 1, dry};
            pg8::gemm_phase<EpiRes, Sched2D>(F.lds, D, Sg, E, F.wave);
        REP_END(pb + 3) }
        SEAM(pb + 3);
        if (PH_EN(4) && IN(pb + 4)) { REP_BEGIN(pb + 4) OPAQUE_WS(); int lq = l; asm volatile("" : "+s"(lq));
            Sched2D Sg{(const char*)(ws + WS_XB), (const char*)(ws + WB_WXQ + lq * SZ_WXQ), NTOK / 256, XW / 256, D, G, c, 0, (NTOK / 256) * (XW / 256)};
            EpiBf<0> E{(bf16_t*)(ws + AR_QX), XW, ssq_ptr(ws, 3 * lq + 1), 0, dry};
            pg8::gemm_phase<EpiBf<0>, Sched2D>(F.lds, D, Sg, E, F.wave);
        REP_END(pb + 4) }
        SEAM(pb + 4);
        if (PH_EN(5) && IN(pb + 5)) { REP_BEGIN(pb + 5) OPAQUE_WS(); int lq = l; asm volatile("" : "+s"(lq));
#ifndef NO_X2
            att::XArgs A{(const bf16_t*)(ws + AR_QX), (const bf16_t*)(ws + WS_KXV) + (size_t)lq * B * MEM * 1024, (bf16_t*)(ws + AR_OX), P.in[20] + lq * XHD, dry};
            for (int u = c; u < B * XH * (S / 256); u += G) { const int qt = u & 15, h = (u >> 4) & 3, b = u >> 6; att::xattn_unit(A, b, h, qt, F.lds, F.wave); }
            __syncthreads();
#endif
        REP_END(pb + 5) }
        SEAM(pb + 5);
        if (PH_EN(6) && IN(pb + 6)) { REP_BEGIN(pb + 6) OPAQUE_WS(); int lq = l; asm volatile("" : "+s"(lq));
            Sched2D Sg{(const char*)(ws + AR_OX), (const char*)(ws + WB_WXO + lq * SZ_WXO), NTOK / 256, D / 256, XW, G, c, 0, (NTOK / 256) * (D / 256)};
            EpiRes E{ws, 3 * lq + 2, dry};
            pg8::gemm_phase<EpiRes, Sched2D>(F.lds, XW, Sg, E, F.wave);
        REP_END(pb + 6) }
        SEAM(pb + 6);
        if (l == 0) {
            if (PH_EN(7) && IN(pb + 7)) { REP_BEGIN(pb + 7) OPAQUE_WS(); int lq = l; asm volatile("" : "+s"(lq));
                { const int gw = F.bid * NWAVES + F.wave, NGW = F.G * NWAVES; const u64_t* ssq = ssq_ptr(ws, 3 * lq + 2); float* rsq = (float*)(ws + WS_RSQ);
                  quant_pass((const bf16_t*)(ws + WS_XB), ws + AR_XQ, rsq, ssq, gw, NGW, F.lane, dry); }
                xcd_barrier(bar);
                Sched2D Sg{(const char*)(ws + AR_XQ), (const char*)(ws + WB_W13), NTOK / 256, 2 * DFF / 256, D / 2, G, c, 0, (NTOK / 256) * (2 * DFF / 256)};
                EpiSwigluI8 E{ws, 0, 0, dry, 0x7fffffff};
                pg8::gemm_phase<EpiSwigluI8, Sched2D, true, true, true>(F.lds, D / 2, Sg, E, F.wave);
            REP_END(pb + 7) }
            SEAM(pb + 7);
            if (PH_EN(8) && IN(pb + 8)) { REP_BEGIN(pb + 8) OPAQUE_WS(); int lq = l; asm volatile("" : "+s"(lq));
                Sched2D Sg{(const char*)(ws + AR_HFF), (const char*)(ws + WB_W2), NTOK / 256, D / 256, DFF / 2, G, c, 0, (NTOK / 256) * (D / 256)};
                EpiResT<true> E{ws, 3 * lq + 3, dry};
                pg8::gemm_phase<EpiResT<true>, Sched2D, true, true, false, true>(F.lds, DFF / 2, Sg, E, F.wave);
            REP_END(pb + 8) }
            SEAM(pb + 8);
        } else {
#ifndef NO_MOE
            if (PH_EN(7) && IN(pb + 7)) { REP_BEGIN(pb + 7) OPAQUE_WS(); int lq = l; asm volatile("" : "+s"(lq)); phase_router(F, P, lq / 2, dry || rerun); phase_moe_weights_a(F, P, lq / 2, dry || rerun); xcd_barrier(bar); phase_moe_weights_b(F, P, lq / 2, dry); phase_moe_gather(F, dry || rerun); REP_END(pb + 7) }
            SEAM(pb + 7);
            if (PH_EN(9) && IN(pb + 9)) { REP_BEGIN(pb + 9) OPAQUE_WS(); int lq = l; asm volatile("" : "+s"(lq));
                LAS int* lpend = (LAS int*)(F.lds + MISC_OFF + 64);
                { int pend[NE], pstart[NE], cnt[NE]; moe_pends(F, pend, pstart, cnt);
                  if (F.tid == 0) {
#pragma unroll
                      for (int e = 0; e < NE; ++e) lpend[e] = pend[e]; } }
                __syncthreads();
                const int R = __builtin_amdgcn_readfirstlane(lpend[NE - 1]) / 256;
                const int nfull = R / MOE_CHUNK_RB, rem0 = nfull * MOE_CHUNK_RB, rem = R - rem0; const bool tail = (rem > 0 && rem <= 16 && nfull >= 2);
                const int nchunk = tail ? nfull : (R + MOE_CHUNK_RB - 1) / MOE_CHUNK_RB;
#pragma unroll 1
                for (int k = 0; k < nchunk; ++k) { const int rb0 = k * MOE_CHUNK_RB, rb1 = (rb0 + MOE_CHUNK_RB < R) ? rb0 + MOE_CHUNK_RB : R;
                    const int nside = (tail && k == 1) ? 4 * rem : 0;
                    if (c < nside) { SchedMoe<false> Sg{ws, lpend, rem0, R, 0, 0, nside, c, 1};
                      EpiBf<3> E{(bf16_t*)(ws + AR_Y), D, (const unsigned*)(ws + CTL_AMAX) + AMAX_W2 + 1, 0, dry};
                      pg8::gemm_phase<EpiBf<3>, SchedMoe<false>, true, true, false, true>(F.lds, DFF / 2, Sg, E, F.wave); }
                    else { SchedMoe<true> Sg{ws, lpend, rb0, rb1, (tail && k == 0) ? rem0 : 0, (tail && k == 0) ? R : 0, G - nside, c - nside, 0};
                      EpiSwigluI8 E{ws, 1, rb0 * 256, dry, (tail && k == 0) ? rem0 * 256 : 0x7fffffff};
                      pg8::gemm_phase<EpiSwigluI8, SchedMoe<true>, true, true, true>(F.lds, D / 2, Sg, E, F.wave); }
                    xcd_barrier(bar);
                    { SchedMoe<false> Sg{ws, lpend, rb0, rb1, 0, 0, G, c, 0};
                      EpiBf<3> E{(bf16_t*)(ws + AR_Y), D, (const unsigned*)(ws + CTL_AMAX) + AMAX_W2 + 1, 0, dry};
                      pg8::gemm_phase<EpiBf<3>, SchedMoe<false>, true, true, false, true>(F.lds, DFF / 2, Sg, E, F.wave); }
                    xcd_barrier(bar);
                }
                F.tid = fresh_tid(F.wave); asm volatile("" : "+v"(F.tid)); F.lane = F.tid & 63;
                phase_moe_combine(F, P, dry);
            REP_END(pb + 9) }
            SEAM(pb + 9);
#endif
        }
    }
#undef IN
#undef SEAM
}

struct Launcher { int grid = 0; };
inline int setup_grid() {
    static int grid = 0;
    if (grid == 0) { int dev = 0, cus = 0; if (hipGetDevice(&dev) != hipSuccess || hipDeviceGetAttribute(&cus, hipDeviceAttributeMultiprocessorCount, dev) != hipSuccess) { grid = -1; return grid; }
        if (hipFuncSetAttribute((const void*)mk_fwd, hipFuncAttributeMaxDynamicSharedMemorySize, LDS_BYTES) != hipSuccess) { grid = -1; return grid; }
        int per_cu = 0; (void)hipOccupancyMaxActiveBlocksPerMultiprocessor(&per_cu, (const void*)mk_fwd, NTHREADS, LDS_BYTES); (void)hipGetLastError();
        grid = (per_cu >= 1) ? cus : -1; }
    return grid;
}
inline void launch_phases(void* const* d_in, float* out, unsigned char* ws, int lo, int hi, int src_is_out, int entry_v, hipStream_t st) {
    const int grid = setup_grid(); if (grid <= 0) return;
    (void)hipMemsetAsync(ws + WS_CTL + (size_t)CW_BAR * 4, 0, (size_t)XCD_BAR_WORDS * 4, st);
    Params p{}; for (int i = 0; i < 31; ++i) p.in[i] = (const float*)d_in[i];
    p.out = out; p.ws = ws; p.ph_lo = lo; p.ph_hi = hi; p.src_is_out = src_is_out; p.entry_v = entry_v;
    hipLaunchKernelGGL(mk_fwd, dim3(grid), dim3(NTHREADS), LDS_BYTES, st, p);
}
}
extern "C" void kernel_launch(void* const* d_in, const int* in_sizes, int n_in, void* d_out, int out_size, void* d_ws, size_t ws_size, hipStream_t stream) {
    if (n_in != 31 || out_size != cfg::NTOK * cfg::D || ws_size < fk::WS_NEED) return;
    unsigned char* ws = (unsigned char*)d_ws; float* out = (float*)d_out;
    (void)hipMemsetAsync(ws + fk::WS_CTL, 0, fk::CTL_BYTES, stream);
#if HYBRID == 0
    fk::launch_phases(d_in, out, ws, 0, fk::N_PHASES, 0, 0, stream);
#elif HYBRID == 1
    fk::launch_phases(d_in, out, ws, 0, 5, 0, 0, stream);
    nv::forward(d_in, out, (char*)d_ws, stream, 0, 1);
#elif HYBRID == 2
    fk::launch_phases(d_in, out, ws, 0, 10, 0, 0, stream);
    nv::forward(d_in, out, (char*)d_ws, stream, 1, 0);
#elif HYBRID == 3
    fk::launch_phases(d_in, out, ws, 0, 17, 0, 0, stream);
    nv::forward(d_in, out, (char*)d_ws, stream, 1, 2);
#endif
}
```

```cpp
#define HYBRID 0
#include <hip/hip_runtime.h>
#include <stdint.h>
#include <math.h>
#include <type_traits>
namespace cfg {
constexpr int D = 1024, B = 8, S = 4096, NTOK = B * S, DEPTH = 2;
constexpr int HD = 64, AH = 8, ABLK = 256, ATOPK = 3, NBLK = S / ABLK;
constexpr int CH = 8, CKV = 2, CW = 128;
constexpr int INC = 5888;
constexpr int OFF_QA = 0, OFF_KA = 512, OFF_VA = 1024, OFF_UB = 1536, OFF_QC = 2048, OFF_KC = 2560, OFF_VC = 2688, OFF_GL = 2816;
constexpr int MEM = 256, XH = 4, XHD = 128, XW = 512;
constexpr int DFF = 3584, NE = 8;
}
namespace fk {
using namespace cfg;
#define LAS __attribute__((address_space(3)))
#define GAS __attribute__((address_space(1)))
typedef unsigned short bf16_t;
typedef short bf16x8 __attribute__((ext_vector_type(8)));
typedef short s16x4 __attribute__((ext_vector_type(4)));
typedef float f32x2 __attribute__((ext_vector_type(2)));
typedef float f32x4 __attribute__((ext_vector_type(4)));
typedef float f32x16 __attribute__((ext_vector_type(16)));
typedef unsigned u32x2 __attribute__((ext_vector_type(2)));
typedef unsigned u32x4 __attribute__((ext_vector_type(4)));
typedef __bf16 bf16x2_t __attribute__((ext_vector_type(2)));
constexpr float EPS = 1e-6f;
constexpr float LOG2E = 1.4426950408889634f;
constexpr float QSCALE64 = 0.125f * LOG2E;
constexpr float QSCALE128 = 0.08838834764831845f * LOG2E;

__device__ __forceinline__ unsigned pk_bf16(float lo, float hi) { f32x2 v = {lo, hi}; bf16x2_t b = __builtin_convertvector(v, bf16x2_t); return __builtin_bit_cast(unsigned, b); }
__device__ __forceinline__ float bf_lo(unsigned w) { return __uint_as_float(w << 16); }
__device__ __forceinline__ float bf_hi(unsigned w) { return __uint_as_float(w & 0xffff0000u); }
__device__ __forceinline__ float bf2f(bf16_t b) { return __uint_as_float(((unsigned)b) << 16); }
__device__ __forceinline__ float wave_sum(float v) {
#pragma unroll
    for (int o = 1; o < 64; o <<= 1) v += __shfl_xor(v, o);
    return v;
}
__device__ __forceinline__ int fresh_lane() {
    unsigned z = 0u; asm volatile("" : "+s"(z));
    return (int)__builtin_amdgcn_mbcnt_hi(~0u, __builtin_amdgcn_mbcnt_lo(~0u, z));
}
__device__ __forceinline__ int fresh_tid(int wave) { return wave * 64 + fresh_lane(); }
__device__ __forceinline__ float fast_exp2(float x) { return __builtin_amdgcn_exp2f(x); }
__device__ __forceinline__ float fast_rcp(float x) { return __builtin_amdgcn_rcpf(x); }
__device__ __forceinline__ float sigmoidf_fast(float x) { return fast_rcp(1.0f + fast_exp2(-x * LOG2E)); }

#define XB_TMO      128
#define XB_XCNT(j)  (256  + 64 * (j))
#define XB_XSUB(j)  (1280 + 64 * (j))
#define XB_XGEN(j)  (2304 + 64 * (j))
#define XB_TOP      3328
#define XB_TOPGEN   3392
#define XCD_BAR_WORDS 3456
#define XB_SPIN_CAP (1u << 18)
__device__ __forceinline__ unsigned xb_ld(unsigned* p)              { return __hip_atomic_load(p, __ATOMIC_RELAXED, __HIP_MEMORY_SCOPE_AGENT); }
__device__ __forceinline__ unsigned xb_add(unsigned* p, unsigned v) { return __hip_atomic_fetch_add(p, v, __ATOMIC_RELAXED, __HIP_MEMORY_SCOPE_AGENT); }
__device__ __forceinline__ unsigned xb_xcc_id() { return (unsigned)__builtin_amdgcn_s_getreg((3 << 11) | 20) & 0xFu; }
#define XB_SPIN(cond, bar) do { unsigned _sp = 0; while (cond) { __builtin_amdgcn_s_sleep(1); \
    if ((++_sp & 255u) == 0u) { if (xb_ld(&(bar)[XB_TMO])) break; if (_sp > XB_SPIN_CAP) { atomicAdd(&(bar)[XB_TMO], 1u); break; } } } } while (0)
struct XcdBarrier { unsigned* bar; unsigned x; volatile LAS unsigned* st; int wave; };
__device__ __forceinline__ XcdBarrier xcd_barrier_post(unsigned* bar, volatile LAS unsigned* st) {
    XcdBarrier b; b.bar = bar; b.x = xb_xcc_id(); b.st = st; b.wave = __builtin_amdgcn_readfirstlane((int)threadIdx.x >> 6);
    if (threadIdx.x == 0) (void)xb_add(&bar[XB_XCNT(b.x)], 1u);
    return b;
}
__device__ __forceinline__ void xcd_barrier_complete(unsigned* bar, unsigned x, unsigned& nloc, unsigned& nx) {
    const unsigned G = gridDim.x * gridDim.y * gridDim.z;
    unsigned sum, cnt, mine, sp = 0u;
    for (;;) {
        sum = 0u; cnt = 0u; mine = 0u;
#pragma unroll
        for (unsigned j = 0; j < 16; ++j) { const unsigned c = xb_ld(&bar[XB_XCNT(j)]); sum += c; cnt += (c > 0u) ? 1u : 0u; mine = (j == x) ? c : mine; }
        if (sum == G) break;
        __builtin_amdgcn_s_sleep(1);
        if ((++sp & 255u) == 0u) { if (xb_ld(&bar[XB_TMO])) break; if (sp > XB_SPIN_CAP) { atomicAdd(&bar[XB_TMO], 1u); break; } }
    }
    nloc = mine > 0u ? mine : 1u; nx = cnt > 0u ? cnt : 1u;
}
__device__ __forceinline__ void xcd_barrier(const XcdBarrier& b) {
    asm volatile("s_waitcnt vmcnt(0)" ::: "memory");
    __syncthreads();
    if (fresh_tid(b.wave) == 0) {
        unsigned* bar = b.bar; asm volatile("" : "+s"(bar));
        __builtin_amdgcn_s_waitcnt(0);
        const unsigned bx = xb_xcc_id();
        unsigned nloc = b.st[0], nx = b.st[1];
        if (nloc == 0u) { xcd_barrier_complete(bar, bx, nloc, nx); b.st[0] = nloc; b.st[1] = nx; }
        const unsigned old = xb_add(&bar[XB_XSUB(bx)], 1u);
        const unsigned gen = old / nloc;
        if (old + 1u == (gen + 1u) * nloc) {
            __builtin_amdgcn_fence(__ATOMIC_RELEASE, "agent");
            asm volatile("s_waitcnt vmcnt(0)" ::: "memory");
            const unsigned og = xb_add(&bar[XB_TOP], 1u);
            const unsigned tg = og / nx;
            if (og + 1u == (tg + 1u) * nx) xb_add(&bar[XB_TOPGEN], 1u);
            else XB_SPIN(xb_ld(&bar[XB_TOPGEN]) == tg, bar);
            __builtin_amdgcn_fence(__ATOMIC_ACQUIRE, "agent");
            xb_add(&bar[XB_XGEN(bx)], 1u);
            asm volatile("s_waitcnt vmcnt(0)" ::: "memory");
        } else {
            XB_SPIN(xb_ld(&bar[XB_XGEN(bx)]) == gen, bar);
            __builtin_amdgcn_fence(__ATOMIC_ACQUIRE, "agent");
            asm volatile("s_waitcnt vmcnt(0)" ::: "memory");
        }
    }
    __syncthreads();
}
}
namespace fk {
namespace pg8 {
constexpr int BM = 256, BK = 64, HALF = 128, HTB = HALF * BK * 2, STAGE_BYTES = 8 * HTB, NXCD = 8;
#ifndef WGM_WIDE
#define WGM_WIDE 4
#endif
#ifndef WGM_NARROW
#define WGM_NARROW 8
#endif
#ifndef WGM_SPLIT
#define WGM_SPLIT 4
#endif
__host__ __device__ __forceinline__ int lds_byte(int r, int c) { const int st = (r >> 4) * 2 + (c >> 5), rr = r & 15, cc = c & 31, ob = rr * 64 + cc * 2; return st * 1024 + (ob ^ (((ob >> 9) & 1) << 5)); }
__host__ __device__ __forceinline__ void stage_rc(int b, int& R, int& C) { const int st = b / 1024, sb = b % 1024, swz = sb ^ (((sb >> 9) & 1) << 5); R = (st >> 1) * 16 + swz / 64; C = (st & 1) * 32 + (swz % 64) / 2; }
__host__ __device__ __forceinline__ int perm32(int rho) { const int n = rho >> 4, i = rho & 15; return 8 * (i >> 2) + 4 * n + (i & 3); }

struct Unit { int pm, pn, sub; const char* a; const char* b; };

__device__ __forceinline__ void tile_order(int L, int nM, int nN, int& pm, int& pn) {
    const int WGM = (nN > WGM_SPLIT) ? WGM_WIDE : WGM_NARROW;
    const int nwg = nM * nN; int wgid = L;
    { const int q = nwg / NXCD, r = nwg % NXCD, xcd = wgid % NXCD, off = wgid / NXCD; wgid = (xcd < r ? xcd * (q + 1) : r * (q + 1) + (xcd - r) * q) + off; }
    const int nig = WGM * nN, gid = wgid / nig, fm = gid * WGM, gsz = (nM - fm) < WGM ? (nM - fm) : WGM;
    pm = fm + ((wgid % nig) % gsz); pn = (wgid % nig) / gsz;
}

template <bool I8, class AccT> __device__ __forceinline__ void mma1(AccT& c, const bf16x8& a, const bf16x8& b) {
    if constexpr (I8) c = __builtin_amdgcn_mfma_i32_16x16x64_i8(__builtin_bit_cast(AccT, a), __builtin_bit_cast(AccT, b), c, 0, 0, 0);
    else c = __builtin_amdgcn_mfma_f32_16x16x32_bf16(a, b, c, 0, 0, 0);
}
typedef int i32x8 __attribute__((ext_vector_type(8)));
__device__ __forceinline__ void mma8(f32x4& c, const bf16x8& a0, const bf16x8& a1, const bf16x8& b0, const bf16x8& b1) {
    typedef int i32x4_ __attribute__((ext_vector_type(4)));
    const i32x8 A = __builtin_shufflevector(__builtin_bit_cast(i32x4_, a0), __builtin_bit_cast(i32x4_, a1), 0, 1, 2, 3, 4, 5, 6, 7), Bv = __builtin_shufflevector(__builtin_bit_cast(i32x4_, b0), __builtin_bit_cast(i32x4_, b1), 0, 1, 2, 3, 4, 5, 6, 7);
    c = __builtin_amdgcn_mfma_scale_f32_16x16x128_f8f6f4(A, Bv, c, 0, 0, 0, 0, 0, 0);
}
typedef int i32x4 __attribute__((ext_vector_type(4)));
template <class Epi, class Sched, bool ALIGN_EPI = true, bool SP2 = true, bool I8 = false, bool F8 = false>
__device__ __forceinline__ void gemm_phase(LAS unsigned char* lds, const int K, const Sched& S, const Epi& E, const int wave) {
    typedef typename std::conditional<I8, i32x4, f32x4>::type acc_t;
    int tid_ = fresh_tid(wave); asm volatile("" : "+v"(tid_));
    const int tid = tid_, wid = __builtin_amdgcn_readfirstlane(tid >> 6), lane = tid & 63, wr = wid >> 2, wc = wid & 3, fr = lane & 15, fq = lane >> 4;
    const int nt = K / BK;
    unsigned voffA, voffB;
    { int R, C; stage_rc(tid * 16, R, C); const int Rb = Epi::PERM ? ((R & ~31) + perm32(R & 31)) : R;
      voffA = (unsigned)(R * K + C) * 2u; voffB = (unsigned)(Rb * K + C) * 2u; }
    const size_t rstep = (size_t)64 * K * 2;
    const size_t kstep = (size_t)(BK * 2);
    const size_t hstep = (size_t)HALF * K * 2;
    const unsigned ldsw = (unsigned)wid * 1024u;
    const int aoff = lds_byte(wr * 64 + fr, fq * 8), boff = lds_byte(wc * 32 + fr, fq * 8);
#define PG8_SA(b, h) (((b) * 2 + (h)) * HTB)
#define PG8_SB(b, h) ((4 + (b) * 2 + (h)) * HTB)
#define PG8_STAGE(bufoff, gbase, voff) do { _Pragma("unroll") for (int _i = 0; _i < 2; ++_i) { const char* gb_ = (const char*)(gbase) + _i * rstep; asm volatile("" : "+s"(gb_));   \
        __builtin_amdgcn_global_load_lds((const unsigned*)(gb_ + (voff)), (LAS unsigned*)(lds + (bufoff) + ldsw + _i * 8192), 16, 0, 0); } } while (0)
#define PG8_LDA(dst, b, h) do { _Pragma("unroll") for (int m = 0; m < 4; ++m) _Pragma("unroll") for (int k = 0; k < 2; ++k) dst[m][k] = *(const LAS bf16x8*)(lds + PG8_SA(b, h) + aoff + m * 2048 + k * 1024); } while (0)
#define PG8_LDB(dst, b, h) do { _Pragma("unroll") for (int n = 0; n < 2; ++n) _Pragma("unroll") for (int k = 0; k < 2; ++k) dst[n][k] = *(const LAS bf16x8*)(lds + PG8_SB(b, h) + boff + n * 2048 + k * 1024); } while (0)
#define PG8_MMA(ai, bj, At, Bt) do { __builtin_amdgcn_s_setprio(1); _Pragma("unroll") for (int m = 0; m < 4; ++m) _Pragma("unroll") for (int n = 0; n < 2; ++n) { \
        if constexpr (F8) mma8(acc[ai][bj][m][n], Bt[n][0], Bt[n][1], At[m][0], At[m][1]); else { _Pragma("unroll") for (int k = 0; k < 2; ++k) mma1<I8>(acc[ai][bj][m][n], Bt[n][k], At[m][k]); } } __builtin_amdgcn_s_setprio(0); } while (0)
#define PG8_WAIT_V(n) asm volatile("s_waitcnt vmcnt(" #n ")" ::: "memory")
#define PG8_WAIT_L(n) asm volatile("s_waitcnt lgkmcnt(" #n ")" ::: "memory")
#define PG8_BAR __builtin_amdgcn_s_barrier()
#define PG8_SCHED __builtin_amdgcn_sched_barrier(0)
    Unit cur, nxt; int ui = 0;
    if (!S.next(0, cur)) return;
    acc_t acc[2][2][4][2];
#pragma unroll
    for (int a = 0; a < 2; ++a)
#pragma unroll
        for (int b = 0; b < 2; ++b)
#pragma unroll
            for (int m = 0; m < 4; ++m)
#pragma unroll
                for (int n = 0; n < 2; ++n) acc[a][b][m][n] = (acc_t){0, 0, 0, 0};
    bf16x8 At[4][2], B0[2][2], B1[2][2];
    const char* cA = cur.a; const char* cB = cur.b;
    if constexpr (SP2) {
        PG8_STAGE(PG8_SB(0, 0), cB, voffB); PG8_STAGE(PG8_SB(0, 1), cB + hstep, voffB); PG8_STAGE(PG8_SA(0, 0), cA, voffA); PG8_STAGE(PG8_SA(0, 1), cA + hstep, voffA);
        if (wr == 1) PG8_BAR;
        PG8_WAIT_V(2); PG8_BAR;
        PG8_STAGE(PG8_SB(1, 0), cB + kstep, voffB); PG8_STAGE(PG8_SA(1, 0), cA + kstep, voffA); PG8_STAGE(PG8_SB(1, 1), cB + hstep + kstep, voffB);
        PG8_WAIT_V(6); PG8_BAR;
    } else {
        PG8_STAGE(PG8_SB(0, 0), cB, voffB); PG8_STAGE(PG8_SA(0, 0), cA, voffA); PG8_STAGE(PG8_SB(0, 1), cB + hstep, voffB); PG8_STAGE(PG8_SA(0, 1), cA + hstep, voffA);
        if (wr == 1) PG8_BAR;
        PG8_WAIT_V(4); PG8_BAR;
        PG8_STAGE(PG8_SB(1, 0), cB + kstep, voffB); PG8_STAGE(PG8_SA(1, 0), cA + kstep, voffA); PG8_STAGE(PG8_SB(1, 1), cB + hstep + kstep, voffB);
        PG8_WAIT_V(6); PG8_BAR;
    }
    for (;;) {
        const bool has_next = S.next(ui + 1, nxt);
        const char* nA = has_next ? nxt.a : cA; const char* nB = has_next ? nxt.b : cB;
        for (int t = 0; t < nt; t += 2) {
            const bool last = (t == nt - 2);
            const char* a1 = cA + (size_t)(t + 1) * kstep;
            const char* a2 = last ? nA : cA + (size_t)(t + 2) * kstep; const char* b2 = last ? nB : cB + (size_t)(t + 2) * kstep;
            const char* a3 = a2 + kstep; const char* b3 = b2 + kstep;
            if constexpr (SP2) {
            PG8_LDB(B0, 0, 0); PG8_LDB(B1, 0, 1); PG8_SCHED; PG8_LDA(At, 0, 0); PG8_STAGE(PG8_SA(1, 1), a1 + hstep, voffA);
            PG8_WAIT_V(8); PG8_WAIT_L(0); PG8_BAR; PG8_MMA(0, 0, At, B0); PG8_MMA(0, 1, At, B1); PG8_BAR; PG8_SCHED;
            PG8_LDA(At, 0, 1); PG8_STAGE(PG8_SB(0, 0), b2, voffB); PG8_STAGE(PG8_SB(0, 1), b2 + hstep, voffB); PG8_STAGE(PG8_SA(0, 0), a2, voffA);
            PG8_WAIT_V(8); PG8_WAIT_L(0); PG8_BAR; PG8_MMA(1, 0, At, B0); PG8_MMA(1, 1, At, B1); PG8_BAR; PG8_SCHED;
            PG8_LDB(B0, 1, 0); PG8_LDB(B1, 1, 1); PG8_SCHED; PG8_LDA(At, 1, 0); PG8_STAGE(PG8_SA(0, 1), a2 + hstep, voffA);
            PG8_WAIT_V(8); PG8_WAIT_L(0); PG8_BAR; PG8_MMA(0, 0, At, B0); PG8_MMA(0, 1, At, B1); PG8_BAR; PG8_SCHED;
            PG8_LDA(At, 1, 1); PG8_STAGE(PG8_SB(1, 0), b3, voffB); PG8_STAGE(PG8_SB(1, 1), b3 + hstep, voffB); PG8_STAGE(PG8_SA(1, 0), a3, voffA);
            PG8_WAIT_V(8); PG8_WAIT_L(0); PG8_BAR; PG8_MMA(1, 0, At, B0); PG8_MMA(1, 1, At, B1); PG8_BAR; PG8_SCHED;
            } else {
            PG8_LDB(B0, 0, 0); PG8_SCHED; PG8_LDA(At, 0, 0); PG8_STAGE(PG8_SA(1, 1), a1 + hstep, voffA);
            PG8_WAIT_L(8); PG8_BAR; PG8_WAIT_L(0); PG8_MMA(0, 0, At, B0); PG8_BAR; PG8_SCHED;
            PG8_LDB(B1, 0, 1); PG8_STAGE(PG8_SB(0, 0), b2, voffB);
            PG8_BAR; PG8_WAIT_L(0); PG8_MMA(0, 1, At, B1); PG8_BAR;
            PG8_LDA(At, 0, 1); PG8_STAGE(PG8_SA(0, 0), a2, voffA);
            PG8_BAR; PG8_WAIT_L(0); PG8_MMA(1, 0, At, B0); PG8_BAR; PG8_SCHED;
            PG8_STAGE(PG8_SB(0, 1), b2 + hstep, voffB);
            PG8_WAIT_V(6); PG8_BAR; PG8_MMA(1, 1, At, B1); PG8_BAR;
            PG8_LDB(B0, 1, 0); PG8_SCHED; PG8_LDA(At, 1, 0); PG8_STAGE(PG8_SA(0, 1), a2 + hstep, voffA);
            PG8_WAIT_L(8); PG8_BAR; PG8_WAIT_L(0); PG8_MMA(0, 0, At, B0); PG8_BAR; PG8_SCHED;
            PG8_LDB(B1, 1, 1); PG8_STAGE(PG8_SB(1, 0), b3, voffB);
            PG8_BAR; PG8_WAIT_L(0); PG8_MMA(0, 1, At, B1); PG8_BAR;
            PG8_LDA(At, 1, 1); PG8_STAGE(PG8_SA(1, 0), a3, voffA);
            PG8_BAR; PG8_WAIT_L(0); PG8_MMA(1, 0, At, B0); PG8_BAR; PG8_SCHED;
            PG8_STAGE(PG8_SB(1, 1), b3 + hstep, voffB);
            PG8_WAIT_V(6); PG8_BAR; PG8_MMA(1, 1, At, B1); PG8_BAR;
            }
        }
        if constexpr (ALIGN_EPI) { if (wr == 0) PG8_BAR; }
        { const int ln_ = fresh_lane();
          E(acc, cur, wr, wc, ln_ & 15, ln_ >> 4); }
        if (!has_next) break;
        if (!(Epi::KEEPS && cur.sub < 2)) {
#pragma unroll
        for (int a = 0; a < 2; ++a)
#pragma unroll
            for (int b = 0; b < 2; ++b)
#pragma unroll
                for (int m = 0; m < 4; ++m)
#pragma unroll
                    for (int n = 0; n < 2; ++n) acc[a][b][m][n] = (acc_t){0, 0, 0, 0};
        }
        cur = nxt; cA = nA; cB = nB; ++ui;
        if constexpr (ALIGN_EPI) { if (wr == 1) PG8_BAR; }
    }
    PG8_WAIT_V(0);
    if constexpr (!ALIGN_EPI) { if (wr == 0) PG8_BAR; }
    PG8_BAR;
#undef PG8_SA
#undef PG8_SB
#undef PG8_STAGE
#undef PG8_LDA
#undef PG8_LDB
#undef PG8_MMA
#undef PG8_WAIT_V
#undef PG8_WAIT_L
#undef PG8_BAR
#undef PG8_SCHED
}
}
}
namespace fk {
constexpr size_t MiB = 1u << 20;
constexpr size_t WS_CTL = 0, CTL_BYTES = 3 * MiB;
constexpr int    CW_BAR = 4096;
constexpr size_t CTL_KMEAN = 256 * 1024;
constexpr size_t CTL_MOE = 800 * 1024;
constexpr size_t CTL_AMAX = 2560 * 1024;
constexpr size_t CTL_SSQ = 1 * MiB;
constexpr size_t WS_MEMB = 3 * MiB;
constexpr size_t WS_KXV = 7 * MiB;
constexpr size_t WS_RSTDM = 15 * MiB;
constexpr size_t WS_LUTA = WS_RSTDM + 16384;
constexpr int    LUTA_N = 1344, LUTA_TOP = 1087;
constexpr size_t WS_LUTC = WS_LUTA + 65536;
constexpr int    LUTC_N = 512, LUTC_TOP = 255;
constexpr size_t WS_TOPE = WS_LUTC + 32768;
constexpr size_t WS_TOPG = WS_TOPE + 262144;
constexpr size_t WS_TOKSLOT = WS_TOPG + 262144;
constexpr size_t WS_SLOTR = WS_TOKSLOT + 262144;
constexpr int    PSLOT = (NTOK * 2 / 256 + NE) * 256;
constexpr size_t WS_CS13 = WS_SLOTR + 278528;
constexpr size_t WS_CS13E = WS_CS13 + 32768;
constexpr size_t WS_RSQ = WS_CS13E + 262144;
constexpr size_t WS_RSQA = WS_RSQ + 131072;
static_assert(WS_RSQA + 131072 <= 17 * MiB, "small region");
constexpr int    AMAX_WIN = 9 * 2 * DFF;
constexpr int    AMAX_GATE = AMAX_WIN + OFF_GL;
constexpr int    AMAX_W2 = AMAX_WIN + 2 * INC;
static_assert(CTL_AMAX + (size_t)(AMAX_W2 + 16) * 4 <= CTL_BYTES, "ctl region");
constexpr size_t WS_WB = 17 * MiB;
constexpr size_t SZ_WIN = (size_t)INC * D * 2, SZ_WBR = (size_t)D * 512 * 2, SZ_WOUT = (size_t)D * D * 2, SZ_WXQ = (size_t)XW * D * 2, SZ_WXKV = (size_t)2 * XW * D * 2, SZ_WXO = (size_t)D * XW * 2;
constexpr size_t SZ_W13 = (size_t)2 * DFF * D  , SZ_W2 = (size_t)D * DFF  , SZ_WG8 = (size_t)3 * D * D  ;
constexpr size_t WB_WIN = WS_WB, WB_WBR = WB_WIN + 2 * SZ_WIN, WB_WOUT = WB_WBR + 6 * SZ_WBR, WB_WXQ = WB_WOUT + 2 * SZ_WOUT, WB_WXKV = WB_WXQ + 2 * SZ_WXQ, WB_WXO = WB_WXKV + 2 * SZ_WXKV,
                 WB_W13 = WB_WXO + 2 * SZ_WXO, WB_W2 = WB_W13 + SZ_W13, WB_WG8 = WB_W2 + SZ_W2, WB_END = WB_WG8 + 2 * SZ_WG8;
static_assert(WB_END <= 79 * MiB, "weights region");
constexpr size_t WS_XB = 79 * MiB;
constexpr size_t WS_AR = 143 * MiB;
constexpr size_t AR_QA = WS_AR, AR_KA = WS_AR + 32 * MiB, AR_VA = WS_AR + 64 * MiB, AR_UB = WS_AR + 96 * MiB, AR_QC = WS_AR + 128 * MiB, AR_KC = WS_AR + 160 * MiB, AR_VC = WS_AR + 168 * MiB,
                 AR_PB = WS_AR + 176 * MiB, AR_G = WS_AR + 208 * MiB, AR_MERGED = AR_KA;
constexpr size_t AR_XQA = WS_AR + 400 * MiB;
constexpr size_t AR_QX = WS_AR, AR_OX = WS_AR + 32 * MiB;
constexpr size_t AR_HFF = WS_AR, AR_XQ = WS_AR + 224 * MiB;
constexpr size_t AR_W13E = WS_AR, AR_W2E = WS_AR + 56 * MiB, AR_XP8 = WS_AR + 112 * MiB, AR_Y = WS_AR + 178 * MiB, AR_HMOE = WS_AR + 310 * MiB, AR_HREM = WS_AR + 422 * MiB;
constexpr int    MOE_CHUNK_RB = 128;
static_assert((size_t)MOE_CHUNK_RB * 256 * DFF <= 112 * MiB, "HMOE region");
constexpr size_t WS_NEED = WS_AR + 450 * MiB;

struct Params {
    const float* in[31]; float* out; unsigned char* ws; int ph_lo, ph_hi; int src_is_out; int entry_v;
};

struct Sched2D {
    const char* A; const char* Bt; int nM, nN, K, G, c; int base, count;
    __device__ __forceinline__ bool next(int i, pg8::Unit& u) const {
        const long L = (long)i * G + c; if (L >= count) return false;
        pg8::tile_order((int)L + base, nM, nN, u.pm, u.pn); u.sub = 0;
        u.a = A + (size_t)u.pm * 256 * K * 2; u.b = Bt + (size_t)u.pn * 256 * K * 2; return true;
    }
};
struct SchedMerge {
    unsigned char* ws; int l, nM, nN, K, G, c;
    __device__ __forceinline__ bool next(int i, pg8::Unit& u) const {
        const int t = i / 3, sub = i - 3 * t; const long L = (long)t * G + c; if (L >= (long)nM * nN) return false;
        pg8::tile_order((int)L, nM, nN, u.pm, u.pn); u.sub = sub;
        const size_t ao = sub == 0 ? AR_QA : sub == 1 ? AR_PB : AR_QC;
        u.a = (const char*)ws + ao + (size_t)u.pm * 256 * K * 2; u.b = (const char*)ws + WB_WBR + (size_t)(l * 3 + sub) * SZ_WBR + (size_t)u.pn * 256 * K * 2; return true;
    }
};
template <bool UP> struct SchedMoe {
    unsigned char* ws; const LAS int* pend; int rb0, rb1, xrb0, xrb1, G, c, hrem;
    static constexpr int NN = UP ? 2 * DFF / 256 : D / 256;
    __device__ __forceinline__ bool next(int i, pg8::Unit& u) const {
        const int nmain = rb1 - rb0, nrb = nmain + (xrb1 - xrb0); const long L = (long)i * G + c; if (c < 0 || nrb <= 0 || L >= (long)nrb * NN) return false;
        int pm, pn; pg8::tile_order((int)L, nrb, NN, pm, pn); const int rb = pm < nmain ? rb0 + pm : xrb0 + (pm - nmain); u.pm = rb; u.pn = pn;
        int e = 0;
#pragma unroll
        for (int j = 0; j < NE - 1; ++j) e += (rb * 256 >= pend[j]) ? 1 : 0;
        e = __builtin_amdgcn_readfirstlane(e);
        u.sub = e;
        if (UP) { u.a = (const char*)ws + AR_XP8 + (size_t)rb * 256 * D; u.b = (const char*)ws + AR_W13E + (size_t)e * SZ_W13 + (size_t)pn * 256 * D; }
        else    { u.a = (const char*)ws + (hrem ? AR_HREM : AR_HMOE) + (size_t)(rb - rb0) * 256 * DFF; u.b = (const char*)ws + AR_W2E + (size_t)e * SZ_W2 + (size_t)pn * 256 * DFF; }
        return true;
    }
};

typedef unsigned long long u64_t;
__device__ __forceinline__ u64_t* ssq_ptr(unsigned char* ws, int v) { return (u64_t*)(ws + CTL_SSQ) + (size_t)v * NTOK; }
__device__ __forceinline__ u64_t ssq_fix(float ss) { return (u64_t)(ss * 16777216.0f); }
__device__ __forceinline__ float rstd_from_fix(u64_t q) { return __builtin_amdgcn_rsqf((float)q * (1.0f / 16777216.0f) * (1.0f / D) + EPS); }
__device__ __forceinline__ float row_rstd(const u64_t* ssq, int row) { return rstd_from_fix(ssq[row]); }
#define ROW_FENCE() asm volatile("" ::: "memory")
__device__ __forceinline__ u32x4 pack8(const f32x4& a, const f32x4& b) { u32x4 w; w.x = pk_bf16(a[0], a[1]); w.y = pk_bf16(a[2], a[3]); w.z = pk_bf16(b[0], b[1]); w.w = pk_bf16(b[2], b[3]); return w; }
__device__ __forceinline__ void unpack8(const u32x4& w, f32x4& a, f32x4& b) { a = (f32x4){bf_lo(w.x), bf_hi(w.x), bf_lo(w.y), bf_hi(w.y)}; b = (f32x4){bf_lo(w.z), bf_hi(w.z), bf_lo(w.w), bf_hi(w.w)}; }

struct EpiIn {
    static constexpr bool PERM = true, KEEPS = false;
    unsigned char* ws; const Params& P; int l; bool dry, noatom;
    __device__ __forceinline__ void operator()(const pg8::i32x4 (&acc)[2][2][4][2], const pg8::Unit& u, int wr, int wc, int fr, int fq) const {
        const float* rsq = (const float*)(ws + WS_RSQA);
        float sq[2][4];
#pragma unroll
        for (int ai = 0; ai < 2; ++ai)
#pragma unroll
            for (int m = 0; m < 4; ++m) sq[ai][m] = rsq[u.pm * 256 + ai * 128 + wr * 64 + m * 16 + fr];
        f32x4 csc[2][2];
        { const float* cp = (const float*)(ws + CTL_AMAX) + AMAX_WIN + l * INC + u.pn * 256 + wc * 32 + 8 * fq;
#pragma unroll
          for (int bj = 0; bj < 2; ++bj)
#pragma unroll
              for (int n = 0; n < 2; ++n) csc[bj][n] = *(const f32x4*)(cp + 128 * bj + 4 * n) * (1.0f / 127.0f); }
        const int pn = u.pn; const int gc0 = 256 * pn + 64 * wc + 8 * fq;
        int kind; bf16_t* dst; int ld, col0; const float* gain = nullptr;
        if (pn < 2) { kind = 2; dst = (bf16_t*)(ws + AR_QA); ld = 512; col0 = gc0; gain = P.in[6] + l * HD; }
        else if (pn < 4) { kind = 1; dst = (bf16_t*)(ws + AR_KA); ld = 512; col0 = gc0 - 512; gain = P.in[7] + l * HD; }
        else if (pn < 6) { kind = 0; dst = (bf16_t*)(ws + AR_VA); ld = 512; col0 = gc0 - 1024; }
        else if (pn < 8) { kind = 0; dst = (bf16_t*)(ws + AR_UB); ld = 512; col0 = gc0 - 1536; }
        else if (pn < 10) { kind = 2; dst = (bf16_t*)(ws + AR_QC); ld = 512; col0 = gc0 - 2048; gain = P.in[10] + l * HD; }
        else if (pn == 10) { if (wc < 2) { kind = 1; dst = (bf16_t*)(ws + AR_KC); ld = 128; col0 = gc0 - 2560; gain = P.in[11] + l * HD; } else { kind = 0; dst = (bf16_t*)(ws + AR_VC); ld = 128; col0 = gc0 - 2688; } }
        else { kind = 0; dst = (bf16_t*)(ws + AR_VC); ld = 128; col0 = 0; }
        const float* bgate = P.in[5] + l * 3 * D;
        f32x4 gv[2][2];
#pragma unroll
        for (int bj = 0; bj < 2; ++bj)
#pragma unroll
            for (int n = 0; n < 2; ++n) {
                if (kind == 1 || kind == 2) { gv[bj][n] = *(const f32x4*)(gain + 32 * bj + 8 * fq + 4 * n); if (kind == 2) gv[bj][n] *= QSCALE64; }
                else if (kind == 3) gv[bj][n] = *(const f32x4*)(bgate + col0 + 32 * bj + 4 * n);
                else gv[bj][n] = (f32x4){1.f, 1.f, 1.f, 1.f};
            }
        const bool do_kmean = (pn == 2 || pn == 3);
        f32x4 cs[2][2];
#pragma unroll
        for (int bj = 0; bj < 2; ++bj)
#pragma unroll
            for (int n = 0; n < 2; ++n) cs[bj][n] = (f32x4){0.f, 0.f, 0.f, 0.f};
#pragma unroll
        for (int ai = 0; ai < 2; ++ai)
#pragma unroll
            for (int m = 0; m < 4; ++m) {
                const int row = u.pm * 256 + ai * 128 + wr * 64 + m * 16 + fr;
                const float rs = sq[ai][m];
                f32x4 v[2][2];
#pragma unroll
                for (int bj = 0; bj < 2; ++bj)
#pragma unroll
                    for (int n = 0; n < 2; ++n)
#pragma unroll
                        for (int j = 0; j < 4; ++j) v[bj][n][j] = (float)acc[ai][bj][m][n][j] * (rs * csc[bj][n][j]);
                if (kind == 1 || kind == 2) {
                    float ss = 0.f;
#pragma unroll
                    for (int bj = 0; bj < 2; ++bj)
#pragma unroll
                        for (int n = 0; n < 2; ++n) ss += (v[bj][n][0] * v[bj][n][0] + v[bj][n][1] * v[bj][n][1]) + (v[bj][n][2] * v[bj][n][2] + v[bj][n][3] * v[bj][n][3]);
                    ss += __shfl_xor(ss, 16); ss += __shfl_xor(ss, 32);
                    const float hr = __builtin_amdgcn_rsqf(ss * (1.0f / HD) + EPS);
#pragma unroll
                    for (int bj = 0; bj < 2; ++bj)
#pragma unroll
                        for (int n = 0; n < 2; ++n) v[bj][n] = v[bj][n] * hr * gv[bj][n];
                    if (do_kmean) {
#pragma unroll
                        for (int bj = 0; bj < 2; ++bj)
#pragma unroll
                            for (int n = 0; n < 2; ++n) cs[bj][n] += v[bj][n];
                    }
                } else if (kind == 3) {
#pragma unroll
                    for (int bj = 0; bj < 2; ++bj)
#pragma unroll
                        for (int n = 0; n < 2; ++n)
#pragma unroll
                            for (int j = 0; j < 4; ++j) v[bj][n][j] = sigmoidf_fast(v[bj][n][j] + gv[bj][n][j]);
                }
                bf16_t* rowp = dst + (size_t)row * ld + col0;
#pragma unroll
                for (int bj = 0; bj < 2; ++bj) if (!dry) *(u32x4*)(rowp + 32 * bj) = pack8(v[bj][0], v[bj][1]);
                ROW_FENCE();
            }
        if (do_kmean) {
#pragma unroll
            for (int bj = 0; bj < 2; ++bj)
#pragma unroll
                for (int n = 0; n < 2; ++n)
#pragma unroll
                    for (int j = 0; j < 4; ++j) { float s = cs[bj][n][j]; s += __shfl_xor(s, 1); s += __shfl_xor(s, 2); s += __shfl_xor(s, 4); s += __shfl_xor(s, 8); cs[bj][n][j] = s; }
            if (fr == 0 && !dry && !noatom) {
                const int b = u.pm / NBLK, blk = u.pm % NBLK, h = 4 * (pn - 2) + wc;
                float* kp = (float*)(ws + CTL_KMEAN) + (((size_t)(l * B + b) * AH + h) * NBLK + blk) * HD;
#pragma unroll
                for (int bj = 0; bj < 2; ++bj)
#pragma unroll
                    for (int n = 0; n < 2; ++n)
#pragma unroll
                        for (int j = 0; j < 4; ++j) atomicAdd(kp + 32 * bj + 8 * fq + 4 * n + j, cs[bj][n][j] * (1.0f / ABLK));
            }
        }
    }
};

template <bool SC> struct EpiResT {
    static constexpr bool PERM = true, KEEPS = false;
    unsigned char* ws; int v; bool dry;
    __device__ __forceinline__ void operator()(const f32x4 (&acc)[2][2][4][2], const pg8::Unit& u, int wr, int wc, int fr, int fq) const {
        bf16_t* xb = (bf16_t*)(ws + WS_XB); u64_t* ssq = ssq_ptr(ws, v);
        float osc = 1.0f; if constexpr (SC) osc = __uint_as_float(((const unsigned*)(ws + CTL_AMAX))[AMAX_W2]) * (1.0f / 256.0f);
        const int col = u.pn * 256 + wc * 32 + 8 * fq;
#pragma unroll
        for (int ai = 0; ai < 2; ++ai) {
            u32x4 bs[4][2];
#pragma unroll
            for (int m = 0; m < 4; ++m) { const size_t off = (size_t)(u.pm * 256 + ai * 128 + wr * 64 + m * 16 + fr) * D + col;
#pragma unroll
                for (int bj = 0; bj < 2; ++bj) bs[m][bj] = *(const u32x4*)(xb + off + bj * 128); }
            ROW_FENCE();
#pragma unroll
            for (int m = 0; m < 4; ++m) {
                const int row = u.pm * 256 + ai * 128 + wr * 64 + m * 16 + fr; const size_t off = (size_t)row * D + col; float ss = 0.f;
                float rsc = osc; if constexpr (SC) asm volatile("" : "+v"(rsc));
#pragma unroll
                for (int bj = 0; bj < 2; ++bj) { f32x4 b0, b1; unpack8(bs[m][bj], b0, b1); const f32x4 x0 = SC ? b0 + acc[ai][bj][m][0] * rsc : b0 + acc[ai][bj][m][0], x1 = SC ? b1 + acc[ai][bj][m][1] * rsc : b1 + acc[ai][bj][m][1];
                    if (!dry) *(u32x4*)(xb + off + bj * 128) = pack8(x0, x1);
                    ss += ((x0[0] * x0[0] + x0[1] * x0[1]) + (x0[2] * x0[2] + x0[3] * x0[3])) + ((x1[0] * x1[0] + x1[1] * x1[1]) + (x1[2] * x1[2] + x1[3] * x1[3])); }
                ss += __shfl_xor(ss, 16); ss += __shfl_xor(ss, 32);
                if (fq == 0 && !dry) atomicAdd(ssq + row, ssq_fix(ss));
            }
            ROW_FENCE();
        }
    }
};

typedef EpiResT<false> EpiRes;

__device__ __forceinline__ size_t gate_tile_off(int pm, int pg, int wr, int wc, int fr, int fq) { return ((size_t)pm * 12 + pg) * 65536 + (size_t)(wr * 4 + wc) * 1024 + (size_t)(fq * 16 + fr) * 16; }
struct EpiMerge {
    static constexpr bool PERM = true, KEEPS = true;
    unsigned char* ws; bool dry;
    __device__ __forceinline__ void operator()(f32x4 (&acc)[2][2][4][2], const pg8::Unit& u, int wr, int wc, int fr, int fq) const {
        bf16_t* M = (bf16_t*)(ws + AR_MERGED);
        const int col = u.pn * 256 + wc * 32 + 8 * fq; const int sub = u.sub;
        const unsigned char* gpw = ws + AR_G + gate_tile_off(u.pm, sub * 4 + u.pn, wr, wc, fr, fq); const unsigned char* gpn = gpw + 4 * 65536;
#pragma unroll
        for (int ai = 0; ai < 2; ++ai) {
            u32x4 gw[4], gn[4];
#pragma unroll
            for (int m = 0; m < 4; ++m) { gw[m] = *(const u32x4*)(gpw + (ai * 4 + m) * 8192); gn[m] = (sub < 2) ? *(const u32x4*)(gpn + (ai * 4 + m) * 8192) : (u32x4){0xffffffffu, 0xffffffffu, 0xffffffffu, 0xffffffffu}; }
            ROW_FENCE();
#pragma unroll
            for (int m = 0; m < 4; ++m) { const int row = u.pm * 256 + ai * 128 + wr * 64 + m * 16 + fr;
#pragma unroll
                for (int bj = 0; bj < 2; ++bj) {
#pragma unroll
                    for (int n = 0; n < 2; ++n)
#pragma unroll
                        for (int j = 0; j < 4; j += 2) { const unsigned w = gw[m][2 * bj + n] >> (8 * j), q = gn[m][2 * bj + n] >> (8 * j);
                            const f32x2 rw = {(float)(w & 255u), (float)((w >> 8) & 255u)}, rq = {fast_rcp((float)(q & 255u)), fast_rcp((float)((q >> 8) & 255u))};
                            const f32x2 a2 = (f32x2){acc[ai][bj][m][n][j], acc[ai][bj][m][n][j + 1]} * (rw * rq); acc[ai][bj][m][n][j] = a2[0]; acc[ai][bj][m][n][j + 1] = a2[1]; }
                    if (sub == 2 && !dry) *(u32x4*)(M + (size_t)row * D + col + bj * 128) = pack8(acc[ai][bj][m][0], acc[ai][bj][m][1]); } }
            ROW_FENCE();
        }
    }
};

template <int MODE> struct EpiBf {
    static constexpr bool PERM = true, KEEPS = false;
    bf16_t* O; int ld; const void* rsrc; int row_off; bool dry;
    __device__ __forceinline__ void operator()(const f32x4 (&acc)[2][2][4][2], const pg8::Unit& u, int wr, int wc, int fr, int fq) const {
        float rsv[2][4];
#pragma unroll
        for (int ai = 0; ai < 2; ++ai)
#pragma unroll
            for (int m = 0; m < 4; ++m) { const int row = u.pm * 256 + ai * 128 + wr * 64 + m * 16 + fr;
                rsv[ai][m] = MODE == 0 ? row_rstd((const u64_t*)rsrc, row) : MODE == 1 ? ((const float*)rsrc)[row] : 1.0f; }
        float usc = 1.0f; if constexpr (MODE == 3) usc = __uint_as_float(((const unsigned*)rsrc)[u.sub]) * (1.0f / 256.0f);
#pragma unroll
        for (int ai = 0; ai < 2; ++ai)
#pragma unroll
            for (int m = 0; m < 4; ++m) {
                const int row = u.pm * 256 + ai * 128 + wr * 64 + m * 16 + fr;
                float rs = rsv[ai][m];
                if constexpr (MODE == 3) { rs = usc; asm volatile("" : "+v"(rs)); }
                bf16_t* rowp = O + (size_t)(row - row_off) * ld + u.pn * 256 + wc * 32 + 8 * fq;
#pragma unroll
                for (int bj = 0; bj < 2; ++bj) if (!dry) *(u32x4*)(rowp + bj * 128) = pack8(acc[ai][bj][m][0] * rs, acc[ai][bj][m][1] * rs);
                ROW_FENCE();
            }
    }
};

template <int MODE> struct EpiSwiglu {
    static constexpr bool PERM = true, KEEPS = false;
    bf16_t* H; const void* rsrc; int row_off; bool dry; int abl;
    __device__ __forceinline__ void operator()(const f32x4 (&acc)[2][2][4][2], const pg8::Unit& u, int wr, int wc, int fr, int fq) const {
        float rsv[2][4];
#pragma unroll
        for (int ai = 0; ai < 2; ++ai)
#pragma unroll
            for (int m = 0; m < 4; ++m) { const int row = u.pm * 256 + ai * 128 + wr * 64 + m * 16 + fr;
                rsv[ai][m] = (abl == 3) ? 1.0f : (MODE == 0 ? row_rstd((const u64_t*)rsrc, row) : ((const float*)rsrc)[row]); }
#pragma unroll
        for (int ai = 0; ai < 2; ++ai)
#pragma unroll
            for (int m = 0; m < 4; ++m) {
                const int row = u.pm * 256 + ai * 128 + wr * 64 + m * 16 + fr;
                const float rs = rsv[ai][m];
                f32x4 h[2];
                if (abl == 1) { h[0] = acc[ai][0][m][0] * rs; h[1] = acc[ai][1][m][1] * rs; }
                else {
#pragma unroll
                for (int n = 0; n < 2; ++n)
#pragma unroll
                    for (int j = 0; j < 4; ++j) { const float a1 = acc[ai][0][m][n][j] * rs, a3 = acc[ai][1][m][n][j] * rs; h[n][j] = a1 * sigmoidf_fast(a1) * a3; }
                }
                const u32x4 w = pack8(h[0], h[1]);
                if (!dry || abl == 1 || abl == 3) *(u32x4*)(H + (size_t)(row - row_off) * DFF + u.pn * 128 + wc * 32 + 8 * fq) = w;
                if (abl == 2) asm volatile("" :: "v"(w.x), "v"(w.y), "v"(w.z), "v"(w.w));
                ROW_FENCE();
            }
    }
};
struct EpiSwigluI8 {
    static constexpr bool PERM = true, KEEPS = false;
    unsigned char* ws; int moe; int row_off; bool dry; int xrow0;
    __device__ __forceinline__ void operator()(const pg8::i32x4 (&acc)[2][2][4][2], const pg8::Unit& u, int wr, int wc, int fr, int fq) const {
        const bool ext = u.pm * 256 >= xrow0; const int roff = ext ? xrow0 : row_off;
        unsigned char* H = ws + (moe ? (ext ? AR_HREM : AR_HMOE) : AR_HFF)  ; const float* rs = (const float*)(ws + (moe ? WS_SLOTR : WS_RSQ));
        const float* cp = (const float*)(ws + CTL_AMAX) + (moe ? (size_t)(1 + u.sub) * 2 * DFF : 0) + u.pn * 256 + wc * 32 + 8 * fq;
        float rsv[2][4];
#pragma unroll
        for (int ai = 0; ai < 2; ++ai)
#pragma unroll
            for (int m = 0; m < 4; ++m) rsv[ai][m] = rs[u.pm * 256 + ai * 128 + wr * 64 + m * 16 + fr];
        f32x4 c1[2], c3[2];
#pragma unroll
        for (int n = 0; n < 2; ++n) { c1[n] = *(const f32x4*)(cp + 4 * n) * (1.0f / 127.0f); c3[n] = *(const f32x4*)(cp + 128 + 4 * n) * (1.0f / 127.0f); }
#pragma unroll
        for (int ai = 0; ai < 2; ++ai)
#pragma unroll
            for (int m = 0; m < 4; ++m) {
                const int row = u.pm * 256 + ai * 128 + wr * 64 + m * 16 + fr; const float r = rsv[ai][m];
                f32x4 h[2];
#pragma unroll
                for (int n = 0; n < 2; ++n)
#pragma unroll
                    for (int j = 0; j < 4; ++j) { const float a1 = (float)acc[ai][0][m][n][j] * (r * c1[n][j]), a3 = (float)acc[ai][1][m][n][j] * (r * c3[n][j]); h[n][j] = a1 * sigmoidf_fast(a1) * a3; }
                u32x2 w;
#pragma unroll
                for (int n = 0; n < 2; ++n) { int pk = __builtin_amdgcn_cvt_pk_fp8_f32(__builtin_amdgcn_fmed3f(h[n][0], -448.f, 448.f), __builtin_amdgcn_fmed3f(h[n][1], -448.f, 448.f), 0, false);
                    pk = __builtin_amdgcn_cvt_pk_fp8_f32(__builtin_amdgcn_fmed3f(h[n][2], -448.f, 448.f), __builtin_amdgcn_fmed3f(h[n][3], -448.f, 448.f), pk, true); w[n] = (unsigned)pk; }
                if (!dry) *(u32x2*)(H + (size_t)(row - roff) * DFF + u.pn * 128 + wc * 32 + 8 * fq) = w;
                ROW_FENCE();
            }
    }
};
struct EpiGateI8 {
    static constexpr bool PERM = true, KEEPS = false;
    unsigned char* ws; const Params& P; int l; bool dry;
    __device__ __forceinline__ void operator()(const pg8::i32x4 (&acc)[2][2][4][2], const pg8::Unit& u, int wr, int wc, int fr, int fq) const {
        unsigned char* G = ws + AR_G + gate_tile_off(u.pm, u.pn, wr, wc, fr, fq); const float* rs = (const float*)(ws + WS_RSQA);
        const int col0 = u.pn * 256 + wc * 32 + 8 * fq;
        const float* cp = (const float*)(ws + CTL_AMAX) + AMAX_GATE + l * INC + col0; const float* bp = P.in[5] + l * 3 * D + col0;
        float rsv[2][4];
#pragma unroll
        for (int ai = 0; ai < 2; ++ai)
#pragma unroll
            for (int m = 0; m < 4; ++m) rsv[ai][m] = rs[u.pm * 256 + ai * 128 + wr * 64 + m * 16 + fr];
        f32x4 cs[2][2], bg[2][2];
#pragma unroll
        for (int bj = 0; bj < 2; ++bj)
#pragma unroll
            for (int n = 0; n < 2; ++n) { cs[bj][n] = *(const f32x4*)(cp + 128 * bj + 4 * n) * (1.0f / 127.0f); bg[bj][n] = *(const f32x4*)(bp + 128 * bj + 4 * n); }
#pragma unroll
        for (int ai = 0; ai < 2; ++ai)
#pragma unroll
            for (int m = 0; m < 4; ++m) {
                const int row = u.pm * 256 + ai * 128 + wr * 64 + m * 16 + fr; const float r = rsv[ai][m];
                u32x4 gq = {0u, 0u, 0u, 0u};
#pragma unroll
                for (int bj = 0; bj < 2; ++bj)
#pragma unroll
                    for (int n = 0; n < 2; ++n)
#pragma unroll
                        for (int j = 0; j < 4; ++j) gq[2 * bj + n] = __builtin_amdgcn_cvt_pk_u8_f32(fmaxf(__builtin_rintf(sigmoidf_fast((float)acc[ai][bj][m][n][j] * (r * cs[bj][n][j]) + bg[bj][n][j]) * 255.0f), 1.0f), j, gq[2 * bj + n]);
                if (!dry) *(u32x4*)(G + (ai * 4 + m) * 8192) = gq;
                ROW_FENCE();
            }
    }
};
}
namespace fk {
namespace att {
constexpr int L_BUF = 0;
constexpr int L_KMEAN = 65536;
constexpr int L_LUT = 69632;
constexpr int L_WSF = 77824;
constexpr int L_OST = 79872;
constexpr int L_END = L_OST + 8 * 8192;
constexpr float NEG = -1e30f;

__device__ __forceinline__ int crow(int r, int hi) { return (r & 3) + 8 * (r >> 2) + 4 * hi; }
__device__ __forceinline__ void glds16(const bf16_t* g, LAS unsigned char* l) { __builtin_amdgcn_global_load_lds((const unsigned*)g, (LAS unsigned*)l, 16, 0, 0); }
typedef short v4i16_t __attribute__((ext_vector_type(4)));
__device__ __forceinline__ s16x4 vtr(const LAS unsigned char* p) { return __builtin_bit_cast(s16x4, __builtin_amdgcn_ds_read_tr16_b64_v4i16((LAS v4i16_t*)p)); }

template <int DH> __device__ __forceinline__ void stage_tile(LAS unsigned char* slot, const bf16_t* kt, const bf16_t* vt, int pitchK, int pitchV, int wid, int lane) {
#pragma unroll
    for (int i = 0; i < DH / 64; ++i) { const int pc = wid + 8 * i; glds16(kt + (size_t)lane * pitchK + pc * 8, slot + pc * 1024); }
#pragma unroll
    for (int i = 0; i < DH / 64; ++i) { const int pv = wid + 8 * i, dg = pv >> 2, kg = pv & 3; glds16(vt + (size_t)(16 * kg + (lane >> 2)) * pitchV + dg * 32 + (lane & 3) * 8, slot + DH * 128 + pv * 1024); }
}
template <int DH> __device__ __forceinline__ void qkt(f32x16& p0, f32x16& p1, const f32x16& c, const LAS unsigned char* Ks, const bf16x8 (&qr)[DH / 16], int r32, int hi) {
    const LAS unsigned char* kb = Ks + hi * 1024 + r32 * 16;
    bf16x8 kf[DH / 8];
#pragma unroll
    for (int d0 = 0; d0 < DH / 16; ++d0) { kf[2 * d0] = *(const LAS bf16x8*)(kb + d0 * 2048); kf[2 * d0 + 1] = *(const LAS bf16x8*)(kb + d0 * 2048 + 512); }
    __builtin_amdgcn_sched_barrier(0);
    p0 = __builtin_amdgcn_mfma_f32_32x32x16_bf16(kf[0], qr[0], c, 0, 0, 0); p1 = __builtin_amdgcn_mfma_f32_32x32x16_bf16(kf[1], qr[0], c, 0, 0, 0);
#pragma unroll
    for (int d0 = 1; d0 < DH / 16; ++d0) { p0 = __builtin_amdgcn_mfma_f32_32x32x16_bf16(kf[2 * d0], qr[d0], p0, 0, 0, 0); p1 = __builtin_amdgcn_mfma_f32_32x32x16_bf16(kf[2 * d0 + 1], qr[d0], p1, 0, 0, 0); }
}
__device__ __forceinline__ void qkt2(f32x16& a0, f32x16& a1, f32x16& b0, f32x16& b1, const f32x16& c, const LAS unsigned char* KsA, const LAS unsigned char* KsB, const bf16x8 (&qr)[4], int r32, int hi) {
    const LAS unsigned char* ka = KsA + hi * 1024 + r32 * 16; const LAS unsigned char* kbp = KsB + hi * 1024 + r32 * 16;
    bf16x8 kf[16];
#pragma unroll
    for (int d0 = 0; d0 < 4; ++d0) { kf[2 * d0] = *(const LAS bf16x8*)(ka + d0 * 2048); kf[2 * d0 + 1] = *(const LAS bf16x8*)(ka + d0 * 2048 + 512); }
#pragma unroll
    for (int d0 = 0; d0 < 4; ++d0) { kf[8 + 2 * d0] = *(const LAS bf16x8*)(kbp + d0 * 2048); kf[8 + 2 * d0 + 1] = *(const LAS bf16x8*)(kbp + d0 * 2048 + 512); }
    __builtin_amdgcn_sched_barrier(0);
    a0 = __builtin_amdgcn_mfma_f32_32x32x16_bf16(kf[0], qr[0], c, 0, 0, 0); a1 = __builtin_amdgcn_mfma_f32_32x32x16_bf16(kf[1], qr[0], c, 0, 0, 0);
#pragma unroll
    for (int d0 = 1; d0 < 4; ++d0) { a0 = __builtin_amdgcn_mfma_f32_32x32x16_bf16(kf[2 * d0], qr[d0], a0, 0, 0, 0); a1 = __builtin_amdgcn_mfma_f32_32x32x16_bf16(kf[2 * d0 + 1], qr[d0], a1, 0, 0, 0); }
    b0 = __builtin_amdgcn_mfma_f32_32x32x16_bf16(kf[8], qr[0], c, 0, 0, 0); b1 = __builtin_amdgcn_mfma_f32_32x32x16_bf16(kf[9], qr[0], c, 0, 0, 0);
#pragma unroll
    for (int d0 = 1; d0 < 4; ++d0) { b0 = __builtin_amdgcn_mfma_f32_32x32x16_bf16(kf[8 + 2 * d0], qr[d0], b0, 0, 0, 0); b1 = __builtin_amdgcn_mfma_f32_32x32x16_bf16(kf[8 + 2 * d0 + 1], qr[d0], b1, 0, 0, 0); }
}
constexpr float SM_THR = 8.0f;
template <int DH> __device__ __forceinline__ void softmax_pv(f32x16& p0, f32x16& p1, f32x16 (&o)[DH / 32], float& mref, float& l, f32x16& cn, bool first, LAS float* wsf, const LAS unsigned char* Vs, int lane, int r32, int hi, int abl = 0) {
    if (abl != 1) {
    float ra = fmaxf(fmaxf(p0[0], p0[1]), p1[0]), rb = fmaxf(fmaxf(p0[2], p0[3]), p1[1]); ra = fmaxf(fmaxf(ra, p1[2]), p1[3]);
#pragma unroll
    for (int r = 4; r < 16; r += 4) { ra = fmaxf(fmaxf(ra, p0[r]), p0[r + 1]); rb = fmaxf(fmaxf(rb, p0[r + 2]), p0[r + 3]); ra = fmaxf(fmaxf(ra, p1[r]), p1[r + 1]); rb = fmaxf(fmaxf(rb, p1[r + 2]), p1[r + 3]); }
    float rm = fmaxf(ra, rb); rm = fmaxf(rm, __shfl_xor(rm, 32));
    if (first || __any(rm > SM_THR)) {
        const float dl = first ? rm : fmaxf(rm, 0.f); mref += dl;
#pragma unroll
        for (int r = 0; r < 16; ++r) { p0[r] -= dl; p1[r] -= dl; cn[r] -= dl; }
        if (!first) { const float f = fast_exp2(-dl); l *= f;
            if (hi == 0) wsf[r32] = f;
            asm volatile("s_waitcnt lgkmcnt(0)" ::: "memory");
#pragma unroll
            for (int g = 0; g < 4; ++g) { const f32x4 a = *(const LAS f32x4*)(wsf + 8 * g + 4 * hi);
#pragma unroll
                for (int db = 0; db < DH / 32; ++db) { o[db][4 * g + 0] *= a[0]; o[db][4 * g + 1] *= a[1]; o[db][4 * g + 2] *= a[2]; o[db][4 * g + 3] *= a[3]; } }
            asm volatile("" ::: "memory"); }
    }
    float ps0 = 0.f, ps1 = 0.f;
#pragma unroll
    for (int r = 0; r < 16; ++r) { p0[r] = fast_exp2(p0[r]); p1[r] = fast_exp2(p1[r]); ps0 += p0[r]; ps1 += p1[r]; }
    l += ps0 + ps1;
    }
    bf16x8 pa[4];
    { u32x4 w;
      w = (u32x4){pk_bf16(p0[0], p0[1]), pk_bf16(p0[2], p0[3]), pk_bf16(p0[4], p0[5]), pk_bf16(p0[6], p0[7])}; pa[0] = __builtin_bit_cast(bf16x8, w);
      w = (u32x4){pk_bf16(p0[8], p0[9]), pk_bf16(p0[10], p0[11]), pk_bf16(p0[12], p0[13]), pk_bf16(p0[14], p0[15])}; pa[1] = __builtin_bit_cast(bf16x8, w);
      w = (u32x4){pk_bf16(p1[0], p1[1]), pk_bf16(p1[2], p1[3]), pk_bf16(p1[4], p1[5]), pk_bf16(p1[6], p1[7])}; pa[2] = __builtin_bit_cast(bf16x8, w);
      w = (u32x4){pk_bf16(p1[8], p1[9]), pk_bf16(p1[10], p1[11]), pk_bf16(p1[12], p1[13]), pk_bf16(p1[14], p1[15])}; pa[3] = __builtin_bit_cast(bf16x8, w); }
    const LAS unsigned char* vb = Vs + (4 * hi + ((lane & 15) >> 2)) * 64 + ((lane >> 4) & 1) * 32 + (lane & 3) * 8;
    if (abl != 2)
#pragma unroll
    for (int db = 0; db < DH / 32; ++db)
#pragma unroll
        for (int ks = 0; ks < 4; ++ks) {
            const s16x4 lo = vtr(vb + db * 4096 + ks * 1024), hh = vtr(vb + db * 4096 + ks * 1024 + 512);
            const bf16x8 vf = (bf16x8){lo[0], lo[1], lo[2], lo[3], hh[0], hh[1], hh[2], hh[3]};
            o[db] = __builtin_amdgcn_mfma_f32_32x32x16_bf16(pa[ks], vf, o[db], 0, 0, 0);
        }
}
__device__ __forceinline__ void softmax_pv2(f32x16& a0, f32x16& a1, f32x16& b0, f32x16& b1, f32x16 (&o)[2], float& mref, float& l, f32x16& cn, bool first, LAS float* wsf,
                                            const LAS unsigned char* VsA, const LAS unsigned char* VsB, int lane, int r32, int hi) {
    float ra = fmaxf(fmaxf(a0[0], a0[1]), a1[0]), rb = fmaxf(fmaxf(a0[2], a0[3]), a1[1]), rc = fmaxf(fmaxf(b0[0], b0[1]), b1[0]), rd = fmaxf(fmaxf(b0[2], b0[3]), b1[1]);
    ra = fmaxf(fmaxf(ra, a1[2]), a1[3]); rc = fmaxf(fmaxf(rc, b1[2]), b1[3]);
#pragma unroll
    for (int r = 4; r < 16; r += 4) { ra = fmaxf(fmaxf(ra, a0[r]), a0[r + 1]); rb = fmaxf(fmaxf(rb, a0[r + 2]), a0[r + 3]); ra = fmaxf(fmaxf(ra, a1[r]), a1[r + 1]); rb = fmaxf(fmaxf(rb, a1[r + 2]), a1[r + 3]);
                                      rc = fmaxf(fmaxf(rc, b0[r]), b0[r + 1]); rd = fmaxf(fmaxf(rd, b0[r + 2]), b0[r + 3]); rc = fmaxf(fmaxf(rc, b1[r]), b1[r + 1]); rd = fmaxf(fmaxf(rd, b1[r + 2]), b1[r + 3]); }
    float rm = fmaxf(fmaxf(ra, rb), fmaxf(rc, rd)); rm = fmaxf(rm, __shfl_xor(rm, 32));
    if (first || __any(rm > SM_THR)) {
        const float dl = first ? rm : fmaxf(rm, 0.f); mref += dl;
#pragma unroll
        for (int r = 0; r < 16; ++r) { a0[r] -= dl; a1[r] -= dl; b0[r] -= dl; b1[r] -= dl; cn[r] -= dl; }
        if (!first) { const float f = fast_exp2(-dl); l *= f;
            if (hi == 0) wsf[r32] = f;
            asm volatile("s_waitcnt lgkmcnt(0)" ::: "memory");
#pragma unroll
            for (int g = 0; g < 4; ++g) { const f32x4 s = *(const LAS f32x4*)(wsf + 8 * g + 4 * hi);
#pragma unroll
                for (int db = 0; db < 2; ++db) { o[db][4 * g + 0] *= s[0]; o[db][4 * g + 1] *= s[1]; o[db][4 * g + 2] *= s[2]; o[db][4 * g + 3] *= s[3]; } }
            asm volatile("" ::: "memory"); }
    }
    float s0 = 0.f, s1 = 0.f, s2 = 0.f, s3 = 0.f;
#pragma unroll
    for (int r = 0; r < 16; ++r) { a0[r] = fast_exp2(a0[r]); a1[r] = fast_exp2(a1[r]); b0[r] = fast_exp2(b0[r]); b1[r] = fast_exp2(b1[r]); s0 += a0[r]; s1 += a1[r]; s2 += b0[r]; s3 += b1[r]; }
    l += (s0 + s1) + (s2 + s3);
    bf16x8 pa[8];
#define PK8(P, B) __builtin_bit_cast(bf16x8, (u32x4){pk_bf16(P[B], P[B + 1]), pk_bf16(P[B + 2], P[B + 3]), pk_bf16(P[B + 4], P[B + 5]), pk_bf16(P[B + 6], P[B + 7])})
    pa[0] = PK8(a0, 0); pa[1] = PK8(a0, 8); pa[2] = PK8(a1, 0); pa[3] = PK8(a1, 8); pa[4] = PK8(b0, 0); pa[5] = PK8(b0, 8); pa[6] = PK8(b1, 0); pa[7] = PK8(b1, 8);
#undef PK8
    const int voff = (4 * hi + ((lane & 15) >> 2)) * 64 + ((lane >> 4) & 1) * 32 + (lane & 3) * 8;
#pragma unroll
    for (int t = 0; t < 2; ++t) { const LAS unsigned char* vb = (t == 0 ? VsA : VsB) + voff;
        s16x4 lo[8], hh[8];
#pragma unroll
        for (int db = 0; db < 2; ++db)
#pragma unroll
            for (int ks = 0; ks < 4; ++ks) { lo[db * 4 + ks] = vtr(vb + db * 4096 + ks * 1024); hh[db * 4 + ks] = vtr(vb + db * 4096 + ks * 1024 + 512); }
        __builtin_amdgcn_sched_barrier(0);
    #pragma unroll
        for (int ks = 0; ks < 4; ++ks)
#pragma unroll
            for (int db = 0; db < 2; ++db) { const int i = db * 4 + ks;
                const bf16x8 vf = (bf16x8){lo[i][0], lo[i][1], lo[i][2], lo[i][3], hh[i][0], hh[i][1], hh[i][2], hh[i][3]};
                o[db] = __builtin_amdgcn_mfma_f32_32x32x16_bf16(pa[4 * t + ks], vf, o[db], 0, 0, 0); }
        }
}
template <int DH> __device__ __forceinline__ void store_o(const f32x16 (&o)[DH / 32], float linv, LAS float* wsf, LAS unsigned char* ost, bf16_t* orow, int pitchO, int lane, int r32, int hi) {
    if (hi == 0) wsf[32 + r32] = linv;
    asm volatile("s_waitcnt lgkmcnt(0)" ::: "memory");
    LAS bf16_t* stg = (LAS bf16_t*)ost;
#pragma unroll
    for (int g = 0; g < 4; ++g) { const f32x4 a = *(const LAS f32x4*)(wsf + 32 + 8 * g + 4 * hi);
#pragma unroll
        for (int j = 0; j < 4; ++j) { const int row = 8 * g + 4 * hi + j;
#pragma unroll
            for (int db = 0; db < DH / 32; ++db) { const unsigned w = pk_bf16(o[db][4 * g + j] * a[j], 0.f); stg[row * DH + db * 32 + r32] = (bf16_t)(w & 0xffffu); } } }
    asm volatile("s_waitcnt lgkmcnt(0)" ::: "memory");
    constexpr int CPR = DH / 8;
#pragma unroll
    for (int i = 0; i < 32 * CPR / 64; ++i) { const int ci = i * 64 + lane, row = ci / CPR, ch = ci % CPR;
        const u32x4 v = *(const LAS u32x4*)(ost + row * (DH * 2) + ch * 16); *(u32x4*)(orow + (size_t)row * pitchO + ch * 8) = v; }
    asm volatile("s_waitcnt lgkmcnt(0)" ::: "memory");
}

struct MobaArgs { const bf16_t *Q, *K, *V; bf16_t* O; const float* kmean; const float* lut; bool dry; int abl;
#ifdef PROBE_UNITCYC
    unsigned* stamp;
#endif
};
__device__ __forceinline__ void moba_unit(const MobaArgs& A, int b, int h, int qb, LAS unsigned char* lds, int wave, bool tables) {
    int tid_ = fresh_tid(wave); asm volatile("" : "+v"(tid_));
    const int tid = tid_, lane = tid & 63, r32 = lane & 31, hi = lane >> 5; const int wid = __builtin_amdgcn_readfirstlane(tid >> 6);
    LAS float* kms = (LAS float*)(lds + L_KMEAN); LAS float* lut = (LAS float*)(lds + L_LUT); LAS float* wsf = (LAS float*)(lds + L_WSF) + wid * 64; LAS unsigned char* ost = lds + L_OST + wid * 8192;
    const int q0 = qb * 256; const size_t rowb = (size_t)b * S;
    const bf16_t* Kh = A.K + rowb * 512 + h * HD; const bf16_t* Vh = A.V + rowb * 512 + h * HD;
    __syncthreads();
    if (tables) {
        for (int i = tid; i < NBLK * HD; i += 512) kms[i] = A.kmean[((size_t)(b * AH + h) * NBLK) * HD + i];
        for (int i = tid; i < LUTA_N; i += 512) lut[i] = A.lut[h * LUTA_N + i]; }
    stage_tile<64>(lds + L_BUF, Kh + (size_t)q0 * 512, Vh + (size_t)q0 * 512, 512, 512, wid, lane);
    const int qpos = q0 + 32 * wid + r32;
    bf16x8 qr[4];
    { const bf16_t* qp = A.Q + (rowb + qpos) * 512 + h * HD + hi * 8;
#pragma unroll
      for (int d0 = 0; d0 < 4; ++d0) qr[d0] = *(const bf16x8*)(qp + d0 * 16); }
    asm volatile("s_waitcnt vmcnt(0) lgkmcnt(0)" ::: "memory");
    __syncthreads();
    unsigned selmask = 0u;
    if (qb > 0) {
        float sc[NBLK];
#pragma unroll
        for (int n = 0; n < NBLK; ++n) { float a = 0.f;
            if (n < qb) {
#pragma unroll
                for (int d0 = 0; d0 < 4; ++d0) { const f32x4 k0 = *(const LAS f32x4*)(kms + n * HD + d0 * 16 + hi * 8), k1 = *(const LAS f32x4*)(kms + n * HD + d0 * 16 + hi * 8 + 4);
                    const u32x4 qw = __builtin_bit_cast(u32x4, qr[d0]);
                    a += bf_lo(qw.x) * k0[0] + bf_hi(qw.x) * k0[1] + bf_lo(qw.y) * k0[2] + bf_hi(qw.y) * k0[3] + bf_lo(qw.z) * k1[0] + bf_hi(qw.z) * k1[1] + bf_lo(qw.w) * k1[2] + bf_hi(qw.w) * k1[3]; }
                a += __shfl_xor(a, 32);
            }
            sc[n] = a; }
#pragma unroll
        for (int r = 0; r < ATOPK; ++r) {
            if (r < qb) { int best = 0; float bv = -INFINITY; bool have = false;
#pragma unroll
                for (int n = 0; n < NBLK; ++n) { const bool ok = (n < qb) && !((selmask >> n) & 1u) && (!have || sc[n] > bv); if (ok) { best = n; bv = sc[n]; have = true; } }
                selmask |= 1u << best; }
        }
    }
    float mref = 0.f, l = 0.f; f32x16 o[2], cn;
    float zf = 0.f; asm volatile("" : "+v"(zf));
#pragma unroll
    for (int r = 0; r < 16; ++r) { o[0][r] = zf; o[1][r] = zf; cn[r] = zf; }
    const int NP = 2 * (qb + 1); const int qmin = q0 + 32 * wid;
    const float bfar = lut[LUTA_TOP - 1000];
    stage_tile<64>(lds + L_BUF + 16384, Kh + (size_t)(q0 + 64) * 512, Vh + (size_t)(q0 + 64) * 512, 512, 512, wid, lane);
#ifdef PROBE_UNITCYC
    const unsigned long long tu0_ = __builtin_readcyclecounter();
#endif
    for (int j = 0; j < NP; ++j) {
        asm volatile("s_waitcnt vmcnt(0)" ::: "memory");
        __syncthreads();
        if (j + 1 < NP) { const int j1 = j + 1; const int kt1 = (j1 < 2) ? q0 + 128 * j1 : 256 * (qb - 1 - ((j1 - 2) >> 1)) + 128 * ((j1 - 2) & 1);
            LAS unsigned char* sl = lds + L_BUF + (j1 & 1) * 32768;
            stage_tile<64>(sl, Kh + (size_t)kt1 * 512, Vh + (size_t)kt1 * 512, 512, 512, wid, lane);
            stage_tile<64>(sl + 16384, Kh + (size_t)(kt1 + 64) * 512, Vh + (size_t)(kt1 + 64) * 512, 512, 512, wid, lane); }
        const bool own = j < 2; const int blk = own ? qb : qb - 1 - ((j - 2) >> 1); const int kt0 = own ? q0 + 128 * j : 256 * blk + 128 * ((j - 2) & 1);
        const bool sel = own || ((selmask >> blk) & 1u);
        const bool skip = (own ? (kt0 > qmin + 31) : !__any(sel)) || A.abl == 5;
        if (!skip) {
            const LAS unsigned char* slot = lds + L_BUF + (j & 1) * 32768;
            const bool near = (qmin - (kt0 + 127) < 790);
            f32x16 a0, a1, b0, b1;
            if (near && __all(sel)) qkt2(a0, a1, b0, b1, cn, slot, slot + 16384, qr, r32, hi);
            else { f32x16 cv; const float badd = near ? 0.f : bfar;
#pragma unroll
                for (int r = 0; r < 16; ++r) cv[r] = sel ? cn[r] + badd : NEG;
                qkt2(a0, a1, b0, b1, cv, slot, slot + 16384, qr, r32, hi); }
            if (near) {
                const LAS float* lp = lut + (LUTA_TOP - qpos + kt0 + 4 * hi);
#pragma unroll
                for (int r = 0; r < 16; ++r) { const int c = (r & 3) + 8 * (r >> 2); a0[r] += lp[c]; a1[r] += lp[c + 32]; b0[r] += lp[c + 64]; b1[r] += lp[c + 96]; }
                if (own && kt0 + 127 > qmin) {
                    const int lim = qpos - kt0 - 4 * hi;
#pragma unroll
                    for (int r = 0; r < 16; ++r) { const int c = (r & 3) + 8 * (r >> 2); if (c > lim) a0[r] = NEG; if (c + 32 > lim) a1[r] = NEG; if (c + 64 > lim) b0[r] = NEG; if (c + 96 > lim) b1[r] = NEG; }
                }
            }
            softmax_pv2(a0, a1, b0, b1, o, mref, l, cn, j == 0, wsf, slot + 8192, slot + 16384 + 8192, lane, r32, hi);
        }
    }
#ifdef PROBE_UNITCYC
    if (A.stamp != nullptr && tid == 0) { const unsigned long long tot = __builtin_readcyclecounter() - tu0_; *A.stamp = __float_as_uint(20.0f + ((float)tot - 150000.0f) * (1.0f / 500.0f)); }
#endif
    const float lt = l + __shfl_xor(l, 32);
    if (!A.dry) store_o<64>(o, fast_rcp(lt), wsf, ost, A.O + (rowb + q0 + 32 * wid) * 512 + h * HD, 512, lane, r32, hi);
}

struct SwaArgs { const bf16_t *Q, *K, *V; bf16_t* O; const float* lut; const float* sinks; bool dry; };
__device__ __forceinline__ void swa_unit(const SwaArgs& A, int b, int kv, int qblk, LAS unsigned char* lds, int wave) {
    int tid_ = fresh_tid(wave); asm volatile("" : "+v"(tid_));
    const int tid = tid_, lane = tid & 63, r32 = lane & 31, hi = lane >> 5; const int wid = __builtin_amdgcn_readfirstlane(tid >> 6);
    LAS float* lut = (LAS float*)(lds + L_LUT); LAS float* wsf = (LAS float*)(lds + L_WSF) + wid * 64; LAS unsigned char* ost = lds + L_OST + wid * 8192;
    const int q0 = qblk * 64, g = wid >> 1, qh = kv * (CH / CKV) + g; const size_t rowb = (size_t)b * S;
    const bf16_t* Kh = A.K + rowb * 128 + kv * HD; const bf16_t* Vh = A.V + rowb * 128 + kv * HD;
    __syncthreads();
    for (int i = tid; i < 4 * LUTC_N; i += 512) lut[i] = A.lut[(kv * 4) * LUTC_N + i];
    const int NT = 1 + (qblk < 2 ? qblk : 2);
    for (int i = 0; i < NT; ++i) stage_tile<64>(lds + L_BUF + i * 16384, Kh + (size_t)(q0 - 64 * i) * 128, Vh + (size_t)(q0 - 64 * i) * 128, 128, 128, wid, lane);
    const int qpos = q0 + 32 * (wid & 1) + r32;
    bf16x8 qr[4];
    { const bf16_t* qp = A.Q + (rowb + qpos) * 512 + qh * HD + hi * 8;
#pragma unroll
      for (int d0 = 0; d0 < 4; ++d0) qr[d0] = *(const bf16x8*)(qp + d0 * 16); }
    float mref = 0.f, l = 0.f; f32x16 o[2], cn;
    float zf = 0.f; asm volatile("" : "+v"(zf));
#pragma unroll
    for (int r = 0; r < 16; ++r) { o[0][r] = zf; o[1][r] = zf; cn[r] = zf; }
    const LAS float* lg = lut + g * LUTC_N;
    asm volatile("s_waitcnt vmcnt(0) lgkmcnt(0)" ::: "memory");
    __syncthreads();
    for (int i = 0; i < NT; ++i) {
        const int kt0 = q0 - 64 * i;
        const LAS unsigned char* slot = lds + L_BUF + i * 16384;
        f32x16 p0, p1; qkt<64>(p0, p1, cn, slot, qr, r32, hi);
        const int d0 = qpos - kt0 - 4 * hi;
        const LAS float* lp = lg + (LUTC_TOP - d0);
#pragma unroll
        for (int r = 0; r < 16; ++r) { const int c = (r & 3) + 8 * (r >> 2);
            const int dd0 = d0 - c, dd1 = d0 - c - 32;
            p0[r] = (dd0 >= 0 && dd0 < CW) ? p0[r] + lp[c] : NEG; p1[r] = (dd1 >= 0 && dd1 < CW) ? p1[r] + lp[c + 32] : NEG; }
        softmax_pv<64>(p0, p1, o, mref, l, cn, i == 0, wsf, slot + 8192, lane, r32, hi);
    }
    const float lt = l + __shfl_xor(l, 32) + fast_exp2(A.sinks[qh] * LOG2E - mref);
    if (!A.dry) store_o<64>(o, fast_rcp(lt), wsf, ost, A.O + (rowb + q0 + 32 * (wid & 1)) * 512 + qh * HD, 512, lane, r32, hi);
}

struct XArgs { const bf16_t* Q; const bf16_t* KV; bf16_t* O; const float* qgain; bool dry; };
__device__ __forceinline__ void xattn_unit(const XArgs& A, int b, int h, int qt, LAS unsigned char* lds, int wave) {
    int tid_ = fresh_tid(wave); asm volatile("" : "+v"(tid_));
    const int tid = tid_, lane = tid & 63, r32 = lane & 31, hi = lane >> 5; const int wid = __builtin_amdgcn_readfirstlane(tid >> 6);
    LAS float* wsf = (LAS float*)(lds + L_WSF) + wid * 64; LAS unsigned char* ost = lds + L_OST + wid * 8192;
    const int q0 = qt * 256; const size_t rowb = (size_t)b * S;
    const bf16_t* Kh = A.KV + (size_t)b * MEM * 1024 + h * XHD; const bf16_t* Vh = Kh + 512;
    __syncthreads();
    stage_tile<128>(lds + L_BUF, Kh, Vh, 1024, 1024, wid, lane);
    const int qpos = q0 + 32 * wid + r32;
    bf16x8 qr[8];
    { const bf16_t* qp = A.Q + (rowb + qpos) * 512 + h * XHD + hi * 8; float qf[8][8]; float ss = 0.f;
#pragma unroll
      for (int d0 = 0; d0 < 8; ++d0) { const u32x4 w = *(const u32x4*)(qp + d0 * 16); f32x4 a, c; unpack8(w, a, c);
#pragma unroll
          for (int j = 0; j < 4; ++j) { qf[d0][j] = a[j]; qf[d0][4 + j] = c[j]; ss += a[j] * a[j] + c[j] * c[j]; } }
      ss += __shfl_xor(ss, 32);
      const float hr = __builtin_amdgcn_rsqf(ss * (1.0f / XHD) + EPS) * QSCALE128;
#pragma unroll
      for (int d0 = 0; d0 < 8; ++d0) { const f32x4 g0 = *(const f32x4*)(A.qgain + d0 * 16 + hi * 8), g1 = *(const f32x4*)(A.qgain + d0 * 16 + hi * 8 + 4);
          u32x4 w; w.x = pk_bf16(qf[d0][0] * hr * g0[0], qf[d0][1] * hr * g0[1]); w.y = pk_bf16(qf[d0][2] * hr * g0[2], qf[d0][3] * hr * g0[3]);
          w.z = pk_bf16(qf[d0][4] * hr * g1[0], qf[d0][5] * hr * g1[1]); w.w = pk_bf16(qf[d0][6] * hr * g1[2], qf[d0][7] * hr * g1[3]); qr[d0] = __builtin_bit_cast(bf16x8, w); } }
    float mref = 0.f, l = 0.f; f32x16 o[4], cn;
    float zf = 0.f; asm volatile("" : "+v"(zf));
#pragma unroll
    for (int r = 0; r < 16; ++r) cn[r] = zf;
#pragma unroll
    for (int db = 0; db < 4; ++db)
#pragma unroll
        for (int r = 0; r < 16; ++r) o[db][r] = zf;
    for (int i = 0; i < 4; ++i) {
        asm volatile("s_waitcnt vmcnt(0) lgkmcnt(0)" ::: "memory");
        __syncthreads();
        if (i + 1 < 4) stage_tile<128>(lds + L_BUF + ((i + 1) & 1) * 32768, Kh + (size_t)(64 * (i + 1)) * 1024, Vh + (size_t)(64 * (i + 1)) * 1024, 1024, 1024, wid, lane);
        const LAS unsigned char* slot = lds + L_BUF + (i & 1) * 32768;
        f32x16 p0, p1; qkt<128>(p0, p1, cn, slot, qr, r32, hi);
        softmax_pv<128>(p0, p1, o, mref, l, cn, i == 0, wsf, slot + 16384, lane, r32, hi);
    }
    const float lt = l + __shfl_xor(l, 32);
    if (!A.dry) store_o<128>(o, fast_rcp(lt), wsf, ost, A.O + (rowb + q0 + 32 * wid) * 512 + h * XHD, 512, lane, r32, hi);
}
}
}
namespace fk {
constexpr int NWAVES = 8, NTHREADS = 512;
constexpr int LDS_BYTES = 147456, MISC_OFF = LDS_BYTES - 128;

__device__ __forceinline__ int rel_bucket(int dist) {
    int n = dist > 0 ? dist : 0;
    if (n < 16) return n;
    int large = 16 + (int)(logf((float)n / 16.0f) / 4.158883083359672f * 16.0f);
    return large < 31 ? large : 31;
}
__device__ __forceinline__ void transpose_item(const float* W, int ldw, int src_col0, int k0, const float* gain, bf16_t* WT, int dst_row0, int Kd, LAS float* scr, int lane, bool dry = false) {
    float tv[32];
#pragma unroll
    for (int i = 0; i < 32; ++i) { const int kk = 2 * i + (lane >> 5); tv[i] = W[(size_t)(k0 + kk) * ldw + src_col0 + (lane & 31)]; }
    if (gain) {
#pragma unroll
        for (int i = 0; i < 32; ++i) tv[i] *= gain[k0 + 2 * i + (lane >> 5)]; }
#pragma unroll
    for (int i = 0; i < 32; ++i) scr[(2 * i + (lane >> 5)) * 33 + (lane & 31)] = tv[i];
    asm volatile("s_waitcnt lgkmcnt(0)" ::: "memory");
    const int c = lane & 7;
#pragma unroll
    for (int j = 0; j < 4; ++j) { const int n = (lane >> 3) + 8 * j; const LAS float* s = scr + (8 * c) * 33 + n;
        u32x4 o; o.x = pk_bf16(s[0 * 33], s[1 * 33]); o.y = pk_bf16(s[2 * 33], s[3 * 33]); o.z = pk_bf16(s[4 * 33], s[5 * 33]); o.w = pk_bf16(s[6 * 33], s[7 * 33]);
        if (!dry) *(u32x4*)(WT + (size_t)(dst_row0 + n) * Kd + k0 + 8 * c) = o; }
    asm volatile("s_waitcnt lgkmcnt(0)" ::: "memory");
}
__device__ __forceinline__ void tj_plain(const float* W, int K, int N, const float* gain, bf16_t* WT, int dst_row_off, LAS float* scr, int item, int lane, bool dry = false) {
    const int nblk = N / 32, kb = item / nblk, nb = item % nblk;
    transpose_item(W, N, nb * 32, kb * 64, gain, WT, dst_row_off + nb * 32, K, scr, lane, dry);
}
__device__ __forceinline__ void tj_win(const float* W, const float* gain, bf16_t* WT, LAS float* scr, int item, int lane) {
    const int nblk = OFF_GL / 32, kb = item / nblk, nb = item % nblk; const int n0 = nb * 32, pn = n0 >> 8, L0 = n0 & 255;
    transpose_item(W, INC, 256 * pn + 64 * ((L0 >> 5) & 3) + 32 * (L0 >> 7), kb * 64, gain, WT, n0, D, scr, lane);
}
__device__ __forceinline__ void tj_w13(const float* W1, const float* W3, const float* gain, bf16_t* WT, LAS float* scr, int item, int lane, bool dry = false) {
    const int nblk = 2 * DFF / 32, kb = item / nblk, nb = item % nblk; const int n0 = nb * 32, t = n0 >> 8, L0 = n0 & 255;
    transpose_item(L0 < 128 ? W1 : W3, DFF, 128 * t + (L0 & 127), kb * 64, gain, WT, n0, D, scr, lane, dry);
}
__device__ __forceinline__ void w13_absmax_item(const float* W1, const float* W3, const float* gain, unsigned* amax, int item, int lane, bool dry = false) {
    const int kq = item & 3, cb = (item >> 2) % (DFF / 64), mat = (item >> 2) / (DFF / 64); const float* W = mat ? W3 : W1; const int j = cb * 64 + lane;
    float am = 0.f;
#pragma unroll 1
    for (int kb = 0; kb < 8; ++kb) { float tv[32];
#pragma unroll
        for (int i = 0; i < 32; ++i) tv[i] = W[(size_t)(kq * 256 + kb * 32 + i) * DFF + j];
#pragma unroll
        for (int i = 0; i < 32; ++i) am = fmaxf(am, fabsf(tv[i] * gain[kq * 256 + kb * 32 + i])); }
    if (!dry) atomicMax(amax + 256 * (j >> 7) + (j & 127) + 128 * mat, __float_as_uint(am));
}
__device__ __forceinline__ void w13_quant_item(const float* W1, const float* W3, const float* gain, const unsigned* amax, unsigned char* WT8, LAS float* scr, int item, int lane, bool dry = false) {
    const int nblk = 2 * DFF / 32, kb = item / nblk, nb = item % nblk; const int n0 = nb * 32, t = n0 >> 8, L0 = n0 & 255; const float* W = L0 < 128 ? W1 : W3; const int col = 128 * t + (L0 & 127) + (lane & 31);
    const float am = __uint_as_float(amax[n0 + (lane & 31)]); const float inv = am > 0.f ? 127.0f / am : 0.f;
    float tv[32];
#pragma unroll
    for (int i = 0; i < 32; ++i) tv[i] = W[(size_t)(kb * 64 + 2 * i + (lane >> 5)) * DFF + col];
#pragma unroll
    for (int i = 0; i < 32; ++i) scr[(2 * i + (lane >> 5)) * 33 + (lane & 31)] = __builtin_rintf(tv[i] * gain[kb * 64 + 2 * i + (lane >> 5)] * inv);
    asm volatile("s_waitcnt lgkmcnt(0)" ::: "memory");
#pragma unroll
    for (int j = 0; j < 2; ++j) { const int idx = lane + 64 * j, n = idx >> 2, c = idx & 3; const LAS float* s = scr + (16 * c) * 33 + n; u32x4 o;
#define Q4(b) (((unsigned)(int)s[(b) * 33] & 255u) | (((unsigned)(int)s[((b) + 1) * 33] & 255u) << 8) | (((unsigned)(int)s[((b) + 2) * 33] & 255u) << 16) | (((unsigned)(int)s[((b) + 3) * 33] & 255u) << 24))
        o.x = Q4(0); o.y = Q4(4); o.z = Q4(8); o.w = Q4(12);
#undef Q4
        if (!dry) *(u32x4*)(WT8 + (size_t)(n0 + n) * D + kb * 64 + 16 * c) = o; }
    asm volatile("s_waitcnt lgkmcnt(0)" ::: "memory");
}
constexpr int I_W2A = (D / 64) * (DFF / 128);
__device__ __forceinline__ void w2_absmax_item(const float* W, unsigned* amax, int item, int lane, bool dry = false) {
    const int cb = item & 15, kq = item >> 4; float am = 0.f;
#pragma unroll 1
    for (int kb = 0; kb < 4; ++kb) { float tv[32];
#pragma unroll
        for (int i = 0; i < 32; ++i) tv[i] = W[(size_t)(kq * 128 + kb * 32 + i) * D + cb * 64 + lane];
#pragma unroll
        for (int i = 0; i < 32; ++i) am = fmaxf(am, fabsf(tv[i])); }
#pragma unroll
    for (int o = 1; o < 64; o <<= 1) am = fmaxf(am, __shfl_xor(am, o));
    if (lane == 0 && !dry) atomicMax(amax, __float_as_uint(am));
}
__device__ __forceinline__ void w2_fp8_item(const float* W, const unsigned* amax, unsigned char* WT8, LAS float* scr, int item, int lane, bool dry = false) {
    const int kb = item >> 5, nb = item & 31, n0 = nb * 32;
    const float am = __uint_as_float(*amax); const float sc = am > 0.f ? 256.0f / am : 0.f;
    float tv[32];
#pragma unroll
    for (int i = 0; i < 32; ++i) tv[i] = W[(size_t)(kb * 64 + 2 * i + (lane >> 5)) * D + n0 + (lane & 31)];
#pragma unroll
    for (int i = 0; i < 32; ++i) scr[(2 * i + (lane >> 5)) * 33 + (lane & 31)] = tv[i] * sc;
    asm volatile("s_waitcnt lgkmcnt(0)" ::: "memory");
#pragma unroll
    for (int j = 0; j < 2; ++j) { const int idx = lane + 64 * j, n = idx >> 2, c = idx & 3; const LAS float* s = scr + (16 * c) * 33 + n; u32x4 o;
#define F4(b) ((unsigned)__builtin_amdgcn_cvt_pk_fp8_f32(s[((b) + 2) * 33], s[((b) + 3) * 33], __builtin_amdgcn_cvt_pk_fp8_f32(s[(b) * 33], s[((b) + 1) * 33], 0, false), true))
        o.x = F4(0); o.y = F4(4); o.z = F4(8); o.w = F4(12);
#undef F4
        if (!dry) *(u32x4*)(WT8 + (size_t)(n0 + n) * DFF + kb * 64 + 16 * c) = o; }
    asm volatile("s_waitcnt lgkmcnt(0)" ::: "memory");
}
__device__ __forceinline__ int win_dest_of_src(int j) { if (j >= OFF_GL) return j; const int s = j & 255; return (j & ~255) + 128 * ((s >> 5) & 1) + 32 * (s >> 6) + (s & 31); }
__device__ __forceinline__ void wg_absmax_item(const float* W, const float* gain, unsigned* amax, int item, int lane) {
    const int kq = item & 3, cb = item >> 2, j = cb * 64 + lane; float am = 0.f;
#pragma unroll 1
    for (int kb = 0; kb < 8; ++kb) { float tv[32];
#pragma unroll
        for (int i = 0; i < 32; ++i) tv[i] = W[(size_t)(kq * 256 + kb * 32 + i) * INC + j];
#pragma unroll
        for (int i = 0; i < 32; ++i) am = fmaxf(am, fabsf(tv[i] * gain[kq * 256 + kb * 32 + i])); }
    atomicMax(amax + win_dest_of_src(j), __float_as_uint(am));
}
__device__ __forceinline__ void wg_quant_item(const float* W, const float* gain, const unsigned* amax, unsigned char* WT8, LAS float* scr, int item, int lane) {
    constexpr int nblk = INC / 32; const int kb = item / nblk, nb = item % nblk, n0 = nb * 32, pn = n0 >> 8, L0 = n0 & 255;
    const int src0 = (n0 < OFF_GL) ? 256 * pn + 64 * ((L0 >> 5) & 3) + 32 * (L0 >> 7) : n0;
    const float am = __uint_as_float(amax[n0 + (lane & 31)]); const float inv = am > 0.f ? 127.0f / am : 0.f;
    float tv[32];
#pragma unroll
    for (int i = 0; i < 32; ++i) tv[i] = W[(size_t)(kb * 64 + 2 * i + (lane >> 5)) * INC + src0 + (lane & 31)];
#pragma unroll
    for (int i = 0; i < 32; ++i) scr[(2 * i + (lane >> 5)) * 33 + (lane & 31)] = __builtin_rintf(tv[i] * gain[kb * 64 + 2 * i + (lane >> 5)] * inv);
    asm volatile("s_waitcnt lgkmcnt(0)" ::: "memory");
#pragma unroll
    for (int j = 0; j < 2; ++j) { const int idx = lane + 64 * j, n = idx >> 2, c = idx & 3; const LAS float* s = scr + (16 * c) * 33 + n; u32x4 o;
#define Q4(b) (((unsigned)(int)s[(b) * 33] & 255u) | (((unsigned)(int)s[((b) + 1) * 33] & 255u) << 8) | (((unsigned)(int)s[((b) + 2) * 33] & 255u) << 16) | (((unsigned)(int)s[((b) + 3) * 33] & 255u) << 24))
        o.x = Q4(0); o.y = Q4(4); o.z = Q4(8); o.w = Q4(12);
#undef Q4
        *(u32x4*)(WT8 + (size_t)(n0 + n) * D + kb * 64 + 16 * c) = o; }
    asm volatile("s_waitcnt lgkmcnt(0)" ::: "memory");
}
__device__ __forceinline__ float quant_row(const bf16_t* xrow, unsigned char* qrow, int lane, bool dry) {
    const u32x4 w0 = ((const u32x4*)xrow)[2 * lane], w1 = ((const u32x4*)xrow)[2 * lane + 1]; f32x4 v[4]; unpack8(w0, v[0], v[1]); unpack8(w1, v[2], v[3]);
    float am = 0.f;
#pragma unroll
    for (int i = 0; i < 4; ++i)
#pragma unroll
        for (int j = 0; j < 4; ++j) am = fmaxf(am, fabsf(v[i][j]));
#pragma unroll
    for (int o = 1; o < 64; o <<= 1) am = fmaxf(am, __shfl_xor(am, o));
    const float sc = am > 0.f ? am * (1.0f / 127.0f) : 1.0f, inv = 1.0f / sc; u32x4 q;
#define Q4(V) (((unsigned)(int)__builtin_rintf(V[0] * inv) & 255u) | (((unsigned)(int)__builtin_rintf(V[1] * inv) & 255u) << 8) | (((unsigned)(int)__builtin_rintf(V[2] * inv) & 255u) << 16) | (((unsigned)(int)__builtin_rintf(V[3] * inv) & 255u) << 24))
    q.x = Q4(v[0]); q.y = Q4(v[1]); q.z = Q4(v[2]); q.w = Q4(v[3]);
#undef Q4
    if (!dry) ((u32x4*)qrow)[lane] = q;
    return sc;
}
__device__ __forceinline__ void quant_pass(const bf16_t* XB, unsigned char* XQ, float* rsq, const u64_t* ssq, int gw, int NGW, int lane, bool dry) {
    for (int r0 = gw; r0 < NTOK; r0 += 4 * NGW) {
        u32x4 w0[4], w1[4]; u64_t sq[4];
#pragma unroll
        for (int k = 0; k < 4; ++k) { const int row = r0 + k * NGW; const int rr = row < NTOK ? row : 0; w0[k] = ((const u32x4*)(XB + (size_t)rr * D))[2 * lane]; w1[k] = ((const u32x4*)(XB + (size_t)rr * D))[2 * lane + 1]; sq[k] = ssq[rr]; }
#pragma unroll
        for (int k = 0; k < 4; ++k) { const int row = r0 + k * NGW; if (row >= NTOK) continue;
            f32x4 v[4]; unpack8(w0[k], v[0], v[1]); unpack8(w1[k], v[2], v[3]);
            float am = 0.f;
#pragma unroll
            for (int i = 0; i < 4; ++i)
#pragma unroll
                for (int j = 0; j < 4; ++j) am = fmaxf(am, fabsf(v[i][j]));
#pragma unroll
            for (int o = 1; o < 64; o <<= 1) am = fmaxf(am, __shfl_xor(am, o));
            const float sc = am > 0.f ? am * (1.0f / 127.0f) : 1.0f, inv = 1.0f / sc; u32x4 q;
#define Q4(V) (((unsigned)(int)__builtin_rintf(V[0] * inv) & 255u) | (((unsigned)(int)__builtin_rintf(V[1] * inv) & 255u) << 8) | (((unsigned)(int)__builtin_rintf(V[2] * inv) & 255u) << 16) | (((unsigned)(int)__builtin_rintf(V[3] * inv) & 255u) << 24))
            q.x = Q4(v[0]); q.y = Q4(v[1]); q.z = Q4(v[2]); q.w = Q4(v[3]);
#undef Q4
            if (!dry) { ((u32x4*)(XQ + (size_t)row * D))[lane] = q; if (lane == 0) rsq[row] = sc * rstd_from_fix(sq[k]); } }
    }
}
__device__ __forceinline__ float row_to_bf16(const float* xrow, bf16_t* orow, int lane) {
    const f32x4* xr = (const f32x4*)xrow + lane; float s = 0.f; u32x2* o8 = (u32x2*)orow + lane;
#pragma unroll
    for (int j = 0; j < 4; ++j) { const f32x4 v = xr[64 * j]; s += (v.x * v.x + v.y * v.y) + (v.z * v.z + v.w * v.w); u32x2 w; w.x = pk_bf16(v.x, v.y); w.y = pk_bf16(v.z, v.w); o8[64 * j] = w; }
    return wave_sum(s);
}
__device__ __forceinline__ void rows4_to_bf16(const float* x, bf16_t* o, unsigned char* xq, int row0, int stride_rows, float (&ss)[4], float (&qs)[4], int lane) {
    f32x4 v[4][4];
#pragma unroll
    for (int r = 0; r < 4; ++r)
#pragma unroll
        for (int j = 0; j < 4; ++j) v[r][j] = (row0 + r * stride_rows < NTOK) ? ((const f32x4*)(x + (size_t)(row0 + r * stride_rows) * D) + lane)[64 * j] : (f32x4){0.f, 0.f, 0.f, 0.f};
#pragma unroll
    for (int r = 0; r < 4; ++r) { float s = 0.f, am = 0.f; const bool ok = row0 + r * stride_rows < NTOK; u32x2* o8 = (u32x2*)(o + (size_t)(row0 + r * stride_rows) * D) + lane;
#pragma unroll
        for (int j = 0; j < 4; ++j) { const f32x4 q = v[r][j]; s += (q.x * q.x + q.y * q.y) + (q.z * q.z + q.w * q.w); am = fmaxf(fmaxf(am, fmaxf(fabsf(q.x), fabsf(q.y))), fmaxf(fabsf(q.z), fabsf(q.w)));
            u32x2 w; w.x = pk_bf16(q.x, q.y); w.y = pk_bf16(q.z, q.w); if (ok) o8[64 * j] = w; }
        ss[r] = wave_sum(s);
#pragma unroll
        for (int of = 1; of < 64; of <<= 1) am = fmaxf(am, __shfl_xor(am, of));
        const float sc = am > 0.f ? am * (1.0f / 127.0f) : 1.0f, inv = 1.0f / sc; qs[r] = sc;
        unsigned* q8 = (unsigned*)(xq + (size_t)(row0 + r * stride_rows) * D) + lane;
#pragma unroll
        for (int j = 0; j < 4; ++j) { const f32x4 q = v[r][j];
            const unsigned w = ((unsigned)(int)__builtin_rintf(q.x * inv) & 255u) | (((unsigned)(int)__builtin_rintf(q.y * inv) & 255u) << 8) | (((unsigned)(int)__builtin_rintf(q.z * inv) & 255u) << 16) | (((unsigned)(int)__builtin_rintf(q.w * inv) & 255u) << 24);
            if (ok) q8[64 * j] = w; } }
}

struct Frame { LAS unsigned char* lds; int tid, lane, wave, G, bid; unsigned char* ws; };

__device__ __forceinline__ void phase_prologue(const Frame& F, const Params& P) {
    LAS float* scr = (LAS float*)(F.lds + F.wave * 16384);
    const int gw = F.bid * NWAVES + F.wave, NGW = F.G * NWAVES, lane = F.lane; unsigned char* ws = F.ws;
    constexpr int I_WIN = 0, I_GA = (INC / 64) * 4, I_BR = (512 / 64) * (D / 32), I_OUT = (D / 64) * (D / 32), I_XQ = (D / 64) * (XW / 32), I_XO = (XW / 64) * (D / 32), I_W13 = 2 * (DFF / 64) * 4  , I_W2 = I_W2A  ;
    constexpr int PER_L = I_WIN + I_GA + 2 * I_BR + I_OUT + I_XQ + 2 * I_XQ + I_XO;
    constexpr int NITEMS = 2 * PER_L + I_W13 + I_W2;
    for (int it = gw; it < NITEMS; it += NGW) {
        int r = it;
        if (r < 2 * PER_L) { const int l = r / PER_L; r -= l * PER_L;
            if (r < I_WIN) { tj_win(P.in[4] + (size_t)l * D * INC, P.in[3] + l * D, (bf16_t*)(ws + WB_WIN + l * SZ_WIN), scr, r, lane); continue; } r -= I_WIN;
            if (r < I_GA) { wg_absmax_item(P.in[4] + (size_t)l * D * INC, P.in[3] + l * D, (unsigned*)(ws + CTL_AMAX) + AMAX_WIN + l * INC, r, lane); continue; } r -= I_GA;
            if (r < I_BR) { tj_plain(P.in[13] + (size_t)(l * 3 + 0) * 512 * D, 512, D, nullptr, (bf16_t*)(ws + WB_WBR + (l * 3 + 0) * SZ_WBR), 0, scr, r, lane); continue; } r -= I_BR;
            if (r < I_BR) { tj_plain(P.in[13] + (size_t)(l * 3 + 2) * 512 * D, 512, D, nullptr, (bf16_t*)(ws + WB_WBR + (l * 3 + 2) * SZ_WBR), 0, scr, r, lane); continue; } r -= I_BR;
            if (r < I_OUT) { tj_plain(P.in[14] + (size_t)l * D * D, D, D, nullptr, (bf16_t*)(ws + WB_WOUT + l * SZ_WOUT), 0, scr, r, lane); continue; } r -= I_OUT;
            if (r < I_XQ) { tj_plain(P.in[17] + (size_t)l * D * XW, D, XW, P.in[15] + l * D, (bf16_t*)(ws + WB_WXQ + l * SZ_WXQ), 0, scr, r, lane); continue; } r -= I_XQ;
            if (r < I_XQ) { tj_plain(P.in[18] + (size_t)l * D * XW, D, XW, P.in[16] + l * D, (bf16_t*)(ws + WB_WXKV + l * SZ_WXKV), 0, scr, r, lane); continue; } r -= I_XQ;
            if (r < I_XQ) { tj_plain(P.in[19] + (size_t)l * D * XW, D, XW, P.in[16] + l * D, (bf16_t*)(ws + WB_WXKV + l * SZ_WXKV), XW, scr, r, lane); continue; } r -= I_XQ;
            tj_plain(P.in[22] + (size_t)l * XW * D, XW, D, nullptr, (bf16_t*)(ws + WB_WXO + l * SZ_WXO), 0, scr, r, lane); continue; }
        r -= 2 * PER_L;
        if (r < I_W13) { w13_absmax_item(P.in[24], P.in[25], P.in[23], (unsigned*)(ws + CTL_AMAX), r, lane); continue; } r -= I_W13;
        w2_absmax_item(P.in[26], (unsigned*)(ws + CTL_AMAX) + AMAX_W2, r, lane);
    }
    __syncthreads();
    { LAS float* Pt = (LAS float*)F.lds;
      LAS float* Bs = Pt + 128 * 128;
      for (int item = F.bid; item < 2 * 4 * 32; item += F.G) { const int nt = item & 31, g = (item >> 5) & 3, l = item >> 7, n0 = nt * 32;
          const float* pw = P.in[8] + (size_t)(l * 4 + g) * 128 * 128; const float* sc = P.in[9] + l * 512 + g * 128; const float* wb = P.in[13] + ((size_t)(l * 3 + 1) * 512 + g * 128) * D + n0;
          for (int i = F.tid; i < 128 * 128; i += NTHREADS) { const int c = i >> 7, d = i & 127; Pt[d * 128 + c] = pw[i] * sc[d]; }
          for (int i = F.tid; i < 128 * 32; i += NTHREADS) { const int d = i >> 5, n = i & 31; Bs[i] = wb[(size_t)d * D + n]; }
          __syncthreads();
          const int n = F.tid & 31, cq = F.tid >> 5; float a[8];
#pragma unroll
          for (int j = 0; j < 8; ++j) a[j] = 0.f;
          for (int d = 0; d < 128; ++d) { const float b = Bs[d * 32 + n]; const f32x4 p0 = *(const LAS f32x4*)(Pt + d * 128 + cq * 8), p1 = *(const LAS f32x4*)(Pt + d * 128 + cq * 8 + 4);
              a[0] += p0[0] * b; a[1] += p0[1] * b; a[2] += p0[2] * b; a[3] += p0[3] * b; a[4] += p1[0] * b; a[5] += p1[1] * b; a[6] += p1[2] * b; a[7] += p1[3] * b; }
          u32x4 w; w.x = pk_bf16(a[0], a[1]); w.y = pk_bf16(a[2], a[3]); w.z = pk_bf16(a[4], a[5]); w.w = pk_bf16(a[6], a[7]);
          *(u32x4*)((bf16_t*)(ws + WB_WBR + (l * 3 + 1) * SZ_WBR) + (size_t)(n0 + n) * 512 + g * 128 + cq * 8) = w;
          __syncthreads(); } }
    { const int gt = F.bid * NTHREADS + F.tid, NGT = F.G * NTHREADS;
      for (int idx = gt; idx < AH * LUTA_N; idx += NGT) { const int h = idx / LUTA_N, i = idx % LUTA_N, dist = LUTA_TOP - i;
          ((float*)(ws + WS_LUTA))[idx] = dist < 0 ? 0.f : P.in[2][rel_bucket(dist) * 16 + h] * LOG2E; }
      for (int idx = gt; idx < CH * LUTC_N; idx += NGT) { const int h = idx / LUTC_N, i = idx % LUTC_N, dist = LUTC_TOP - i;
          ((float*)(ws + WS_LUTC))[idx] = dist < 0 ? 0.f : P.in[2][rel_bucket(dist) * 16 + 8 + h] * LOG2E; } }
    { const float* xsrc = P.src_is_out ? P.out : P.in[0]; bf16_t* XB = (bf16_t*)(ws + WS_XB); u64_t* ssq = ssq_ptr(ws, P.entry_v);
      for (int m = gw; m < NTOK; m += 4 * NGW) { float ss[4], qs[4]; rows4_to_bf16(xsrc, XB, ws + AR_XQA, m, NGW, ss, qs, lane);
          if (lane == 0) {
#pragma unroll
              for (int r = 0; r < 4; ++r) if (m + r * NGW < NTOK) { ssq[m + r * NGW] = ssq_fix(ss[r]); ((float*)(ws + WS_RSQA))[m + r * NGW] = qs[r] * __builtin_amdgcn_rsqf(ss[r] * (1.0f / D) + EPS); } } }
      bf16_t* MB = (bf16_t*)(ws + WS_MEMB); float* rm = (float*)(ws + WS_RSTDM);
      for (int m = gw; m < B * MEM; m += NGW) { const float s = row_to_bf16(P.in[1] + (size_t)m * D, MB + (size_t)m * D, lane); if (lane == 0) rm[m] = __builtin_amdgcn_rsqf(s * (1.0f / D) + EPS); } }
}

template <int WIN> __device__ __forceinline__ void pool_strip(const bf16_t* UB, bf16_t* PB, int t0, int ch, bool dry) {
    const int s0 = t0 & (S - 1);
    u32x4 R[WIN - 1 + 16];
#pragma unroll
    for (int k = 0; k < WIN - 1 + 16; ++k) { const int dt = k - (WIN - 1); R[k] = (s0 + dt >= 0) ? *(const u32x4*)(UB + (size_t)(t0 + dt) * 512 + ch * 8) : (u32x4){0u, 0u, 0u, 0u}; }
    f32x4 a0 = {0.f, 0.f, 0.f, 0.f}, a1 = a0;
#pragma unroll
    for (int k = 0; k < WIN - 1; ++k) { f32x4 x0, x1; unpack8(R[k], x0, x1); a0 += x0; a1 += x1; }
#pragma unroll
    for (int i = 0; i < 16; ++i) { f32x4 x0, x1; unpack8(R[WIN - 1 + i], x0, x1); a0 += x0; a1 += x1;
        const int cnt = (s0 + i + 1 < WIN) ? s0 + i + 1 : WIN; const float inv = 1.0f / (float)cnt;
        if (!dry) *(u32x4*)(PB + (size_t)(t0 + i) * 512 + ch * 8) = pack8(a0 * inv - x0, a1 * inv - x1);
        f32x4 y0, y1; unpack8(R[i], y0, y1); a0 -= y0; a1 -= y1; }
}
__device__ __forceinline__ void phase_pool(const Frame& F, bool dry) {
    const bf16_t* UB = (const bf16_t*)(F.ws + AR_UB); bf16_t* PB = (bf16_t*)(F.ws + AR_PB);
    const int gw = F.bid * NWAVES + F.wave, NGW = F.G * NWAVES, lane = F.lane;
    for (int it = gw; it < 4 * (NTOK / 64); it += NGW) { const int g = it & 3, it4 = it >> 2; const int strip = 4 * it4 + (lane >> 4), ch = 16 * g + (lane & 15), t0 = strip * 16;
        if (g == 0) pool_strip<2>(UB, PB, t0, ch, dry); else if (g == 1) pool_strip<4>(UB, PB, t0, ch, dry); else if (g == 2) pool_strip<8>(UB, PB, t0, ch, dry); else pool_strip<16>(UB, PB, t0, ch, dry); }
}
__device__ __forceinline__ void phase_kxnorm(const Frame& F, const Params& P) {
    const int gw = F.bid * NWAVES + F.wave, NGW = F.G * NWAVES, lane = F.lane;
    for (int it = gw; it < 2 * B * MEM * XH; it += NGW) { const int h = it & 3, row = (it >> 2) & (B * MEM - 1), l = it >> 13;
        bf16_t* p = (bf16_t*)(F.ws + WS_KXV) + ((size_t)l * B * MEM + row) * 1024 + h * XHD + 2 * lane; const unsigned w = *(const unsigned*)p;
        const float a = bf_lo(w), b = bf_hi(w); const float ss = wave_sum(a * a + b * b); const float r = __builtin_amdgcn_rsqf(ss * (1.0f / XHD) + EPS); const float* g = P.in[21] + l * XHD + 2 * lane;
        *(unsigned*)p = pk_bf16(a * r * g[0], b * r * g[1]); }
}

__device__ __forceinline__ void phase_router(const Frame& F, const Params& P, int mi, bool dry) {
    LAS unsigned* lcnt = (LAS unsigned*)(F.lds); LAS unsigned* lbase = lcnt + 8;
    const bf16_t* xb = (const bf16_t*)(F.ws + WS_XB); const u64_t* ssq = ssq_ptr(F.ws, 5); const float* gain = P.in[23] + 1 * D; const float* router = P.in[27] + (size_t)mi * D * NE;
    int* tope = (int*)(F.ws + WS_TOPE); float* topg = (float*)(F.ws + WS_TOPG); int* rank = (int*)(F.ws + WS_TOKSLOT); unsigned* gcnt = (unsigned*)(F.ws + CTL_MOE);
    const int lane = F.lane;
    float rw[16][NE];
#pragma unroll
    for (int q = 0; q < 4; ++q)
#pragma unroll
        for (int i = 0; i < 4; ++i) { const int cc = (q * 64 + lane) * 4 + i; const f32x4 ra = *(const f32x4*)(router + (size_t)cc * NE), rb = *(const f32x4*)(router + (size_t)cc * NE + 4); const float gg = gain[cc];
            rw[q * 4 + i][0] = ra[0] * gg; rw[q * 4 + i][1] = ra[1] * gg; rw[q * 4 + i][2] = ra[2] * gg; rw[q * 4 + i][3] = ra[3] * gg; rw[q * 4 + i][4] = rb[0] * gg; rw[q * 4 + i][5] = rb[1] * gg; rw[q * 4 + i][6] = rb[2] * gg; rw[q * 4 + i][7] = rb[3] * gg; }
    for (int blk = F.bid; blk < NTOK / 128; blk += F.G) {
        const int base = blk * 128;
        __syncthreads();
        if (F.tid < 8) lcnt[F.tid] = 0u;
        __syncthreads();
#pragma unroll 1
        for (int j4 = 0; j4 < 16; j4 += 4) {
            u32x2 xw[4][4]; u64_t sqv[4];
#pragma unroll
            for (int jj = 0; jj < 4; ++jj) { const int tok = base + F.wave * 16 + j4 + jj; sqv[jj] = ssq[tok];
#pragma unroll
                for (int q = 0; q < 4; ++q) xw[jj][q] = *(const u32x2*)(xb + (size_t)tok * D + (q * 64 + lane) * 4); }
#pragma unroll
            for (int jj = 0; jj < 4; ++jj) { const int tok = base + F.wave * 16 + j4 + jj; const float rs = rstd_from_fix(sqv[jj]);
                float lg[NE];
#pragma unroll
                for (int e = 0; e < NE; ++e) lg[e] = 0.f;
#pragma unroll
                for (int q = 0; q < 4; ++q) { const u32x2 w = xw[jj][q]; const float xv[4] = {bf_lo(w.x), bf_hi(w.x), bf_lo(w.y), bf_hi(w.y)};
#pragma unroll
                    for (int i = 0; i < 4; ++i)
#pragma unroll
                        for (int e = 0; e < NE; ++e) lg[e] += xv[i] * rw[q * 4 + i][e]; }
#pragma unroll
                for (int e = 0; e < NE; ++e) lg[e] = wave_sum(lg[e]) * rs;
                int e0 = 0; float v0 = lg[0];
#pragma unroll
                for (int e = 1; e < NE; ++e) if (lg[e] > v0) { e0 = e; v0 = lg[e]; }
                int e1 = -1; float v1 = -INFINITY;
#pragma unroll
                for (int e = 0; e < NE; ++e) if (e != e0 && (e1 < 0 || lg[e] > v1)) { e1 = e; v1 = lg[e]; }
                const float g1 = __expf(v1 - v0), den = 1.f / (1.f + g1);
                if (lane == 0 && !dry) { const unsigned r0 = __hip_atomic_fetch_add(lcnt + e0, 1u, __ATOMIC_RELAXED, __HIP_MEMORY_SCOPE_WORKGROUP), r1 = __hip_atomic_fetch_add(lcnt + e1, 1u, __ATOMIC_RELAXED, __HIP_MEMORY_SCOPE_WORKGROUP);
                    tope[tok * 2] = e0; tope[tok * 2 + 1] = e1; topg[tok * 2] = den; topg[tok * 2 + 1] = g1 * den; rank[tok * 2] = (int)r0; rank[tok * 2 + 1] = (int)r1; } } }
        asm volatile("s_waitcnt vmcnt(0) lgkmcnt(0)" ::: "memory");
        __syncthreads();
        if (F.tid < 8 && !dry) lbase[F.tid] = atomicAdd(gcnt + F.tid, lcnt[F.tid]);
        __syncthreads();
        if (F.tid < 256 && !dry) { const int a = base * 2 + F.tid; rank[a] += (int)lbase[tope[a]]; }
    }
    __syncthreads();
}
__device__ __forceinline__ void phase_moe_weights_a(const Frame& F, const Params& P, int mi, bool dry) {
    const int gw = F.bid * NWAVES + F.wave, NGW = F.G * NWAVES, lane = F.lane; constexpr int I_A = 2 * (DFF / 64) * 4;
    for (int it = gw; it < NE * (I_A + I_W2A); it += NGW) { const int e = it / (I_A + I_W2A), r = it - e * (I_A + I_W2A); const size_t eo = ((size_t)mi * NE + e) * D * DFF;
        if (r < I_A) w13_absmax_item(P.in[28] + eo, P.in[29] + eo, P.in[23] + 1 * D, (unsigned*)(F.ws + CTL_AMAX) + (1 + e) * 2 * DFF, r, lane, dry);
        else w2_absmax_item(P.in[30] + eo, (unsigned*)(F.ws + CTL_AMAX) + AMAX_W2 + 1 + e, r - I_A, lane, dry); }
}
__device__ __forceinline__ void phase_moe_weights_b(const Frame& F, const Params& P, int mi, bool dry) {
    LAS float* scr = (LAS float*)(F.lds + 1024 + F.wave * 16384);
    const int gw = F.bid * NWAVES + F.wave, NGW = F.G * NWAVES, lane = F.lane;
    constexpr int I_W13 = (D / 64) * (2 * DFF / 32), I_W2 = (DFF / 64) * (D / 32), PER_E = I_W13 + I_W2;
    for (int it0 = gw; it0 < NE * PER_E; it0 += NGW) { const int it = NE * PER_E - 1 - it0;
        const int e = it / PER_E; int r = it - e * PER_E; const size_t eo = ((size_t)mi * NE + e) * D * DFF;
        if (r < I_W13) w13_quant_item(P.in[28] + eo, P.in[29] + eo, P.in[23] + 1 * D, (const unsigned*)(F.ws + CTL_AMAX) + (1 + e) * 2 * DFF, F.ws + AR_W13E + (size_t)e * SZ_W13, scr, r, lane, dry);
        else w2_fp8_item(P.in[30] + eo, (const unsigned*)(F.ws + CTL_AMAX) + AMAX_W2 + 1 + e, F.ws + AR_W2E + (size_t)e * SZ_W2, scr, r - I_W13, lane, dry); }
}
__device__ __forceinline__ void phase_dense_w13_b(const Frame& F, const Params& P) {
    LAS float* scr = (LAS float*)(F.lds + F.wave * 16384);
    const int gw = F.bid * NWAVES + F.wave, NGW = F.G * NWAVES, lane = F.lane; constexpr int I_W13 = (D / 64) * (2 * DFF / 32);
    for (int it = gw; it < I_W13; it += NGW) w13_quant_item(P.in[24], P.in[25], P.in[23], (const unsigned*)(F.ws + CTL_AMAX), F.ws + WB_W13, scr, it, lane);
    constexpr int I_W2 = (DFF / 64) * (D / 32);
    for (int it = gw; it < I_W2; it += NGW) w2_fp8_item(P.in[26], (const unsigned*)(F.ws + CTL_AMAX) + AMAX_W2, F.ws + WB_W2, scr, it, lane);
    constexpr int I_GB = (D / 64) * (INC / 32);
    for (int it = gw; it < 2 * I_GB; it += NGW) { const int l = it / I_GB, r = it - l * I_GB;
        wg_quant_item(P.in[4] + (size_t)l * D * INC, P.in[3] + l * D, (const unsigned*)(F.ws + CTL_AMAX) + AMAX_WIN + l * INC, F.ws + WB_WIN + (size_t)l * SZ_WIN, scr, r, lane); }
    __syncthreads();
}
__device__ __forceinline__ void moe_pends(const Frame& F, int (&pend)[NE], int (&pstart)[NE], int (&cnt)[NE]) {
    const unsigned* gcnt = (const unsigned*)(F.ws + CTL_MOE); int acc = 0;
#pragma unroll
    for (int e = 0; e < NE; ++e) { cnt[e] = (int)__hip_atomic_load(gcnt + e, __ATOMIC_RELAXED, __HIP_MEMORY_SCOPE_AGENT); pstart[e] = acc; acc += (cnt[e] + 255) / 256 * 256; pend[e] = acc; }
}
__device__ __forceinline__ void phase_moe_gather(const Frame& F, bool dry) {
    int pend[NE], pstart[NE], cnt[NE]; moe_pends(F, pend, pstart, cnt);
    const int gw = F.bid * NWAVES + F.wave, NGW = F.G * NWAVES, lane = F.lane;
    const int* tope = (const int*)(F.ws + WS_TOPE); int* tokslot = (int*)(F.ws + WS_TOKSLOT); float* slotr = (float*)(F.ws + WS_SLOTR); const u64_t* ssq = ssq_ptr(F.ws, 5);
    const bf16_t* XB = (const bf16_t*)(F.ws + WS_XB); unsigned char* XP8 = F.ws + AR_XP8;
    for (int t0 = gw; t0 < NTOK; t0 += 2 * NGW) {
        u32x4 w0[2], w1[2]; int e[4], rk[4]; u64_t sq[2];
#pragma unroll
        for (int k = 0; k < 2; ++k) { const int tok = t0 + k * NGW; const bool ok = tok < NTOK; const int tk = ok ? tok : 0;
            w0[k] = ((const u32x4*)(XB + (size_t)tk * D))[2 * lane]; w1[k] = ((const u32x4*)(XB + (size_t)tk * D))[2 * lane + 1];
            e[2 * k] = tope[2 * tk]; e[2 * k + 1] = tope[2 * tk + 1]; rk[2 * k] = tokslot[2 * tk]; rk[2 * k + 1] = tokslot[2 * tk + 1]; sq[k] = ssq[tk]; }
#pragma unroll
        for (int k = 0; k < 2; ++k) { const int tok = t0 + k * NGW; if (tok >= NTOK) continue;
            f32x4 v[4]; unpack8(w0[k], v[0], v[1]); unpack8(w1[k], v[2], v[3]);
            float am = 0.f;
#pragma unroll
            for (int i = 0; i < 4; ++i)
#pragma unroll
                for (int j = 0; j < 4; ++j) am = fmaxf(am, fabsf(v[i][j]));
#pragma unroll
            for (int o = 1; o < 64; o <<= 1) am = fmaxf(am, __shfl_xor(am, o));
            const float sc = am > 0.f ? am * (1.0f / 127.0f) : 1.0f, inv = 1.0f / sc; u32x4 q;
#define Q4(V) (((unsigned)(int)__builtin_rintf(V[0] * inv) & 255u) | (((unsigned)(int)__builtin_rintf(V[1] * inv) & 255u) << 8) | (((unsigned)(int)__builtin_rintf(V[2] * inv) & 255u) << 16) | (((unsigned)(int)__builtin_rintf(V[3] * inv) & 255u) << 24))
            q.x = Q4(v[0]); q.y = Q4(v[1]); q.z = Q4(v[2]); q.w = Q4(v[3]);
#undef Q4
            const float rr = rstd_from_fix(sq[k]);
#pragma unroll
            for (int s2 = 0; s2 < 2; ++s2) { const int ee = e[2 * k + s2]; int ps = 0;
#pragma unroll
                for (int j = 0; j < NE; ++j) ps = (ee == j) ? pstart[j] : ps;
                const int slot = ps + rk[2 * k + s2];
                if (!dry) { ((u32x4*)(XP8 + (size_t)slot * D))[lane] = q; if (lane == 0) { tokslot[2 * tok + s2] = slot; slotr[slot] = sc * rr; } } } }
    }
    for (int it = gw; it < NE * 256; it += NGW) { const int e = it >> 8, j = it & 255; int ps = 0, pe = 0, c = 0;
#pragma unroll
        for (int q = 0; q < NE; ++q) { ps = (e == q) ? pstart[q] : ps; pe = (e == q) ? pend[q] : pe; c = (e == q) ? cnt[q] : c; }
        const unsigned zz = (unsigned)F.tid >> 20;
        const int slot = ps + c + j; if (slot < pe && !dry) { ((u32x4*)(XP8 + (size_t)slot * D))[lane] = (u32x4){zz, zz, zz, zz}; if (lane == 0) slotr[slot] = 0.f; } }
}
__device__ __forceinline__ void phase_moe_combine(const Frame& F, const Params& P, bool dry) {
    const int gw = F.bid * NWAVES + F.wave, NGW = F.G * NWAVES, lane = F.lane;
    const int* tokslot = (const int*)(F.ws + WS_TOKSLOT); const float* topg = (const float*)(F.ws + WS_TOPG); const bf16_t* Y = (const bf16_t*)(F.ws + AR_Y); float* out = P.out;
    const bf16_t* XB = (const bf16_t*)(F.ws + WS_XB);
    for (int t0 = gw; t0 < NTOK; t0 += 4 * NGW) {
        int s0[4], s1[4]; float g0[4], g1[4];
#pragma unroll
        for (int k = 0; k < 4; ++k) { const int tok = t0 + k * NGW; const int tk = tok < NTOK ? tok : 0; s0[k] = tokslot[tk * 2]; s1[k] = tokslot[tk * 2 + 1]; g0[k] = topg[tk * 2]; g1[k] = topg[tk * 2 + 1]; }
#pragma unroll
        for (int q = 0; q < 2; ++q) { const int c = (q * 64 + lane) * 8; u32x4 w0[4], w1[4], wx[4];
#pragma unroll
            for (int k = 0; k < 4; ++k) { const int tok = t0 + k * NGW; const int tk = tok < NTOK ? tok : 0; w0[k] = *(const u32x4*)(Y + (size_t)s0[k] * D + c); w1[k] = *(const u32x4*)(Y + (size_t)s1[k] * D + c); wx[k] = *(const u32x4*)(XB + (size_t)tk * D + c); }
#pragma unroll
            for (int k = 0; k < 4; ++k) { const int tok = t0 + k * NGW; if (tok >= NTOK) continue;
                f32x4 a0, a1, b0, b1, x0, x1; unpack8(w0[k], a0, a1); unpack8(w1[k], b0, b1); unpack8(wx[k], x0, x1); f32x4* o = (f32x4*)(out + (size_t)tok * D + c);
                const f32x4 r0 = x0 + a0 * g0[k] + b0 * g1[k], r1 = x1 + a1 * g0[k] + b1 * g1[k]; if (!dry) { o[0] = r0; o[1] = r1; } } } }
}

constexpr int N_PHASES = 20;
__global__ void __launch_bounds__(NTHREADS, 2) mk_fwd(Params P) {
    extern __shared__ __attribute__((aligned(16))) unsigned char lds_raw[];
    Frame F; F.lds = (LAS unsigned char*)lds_raw; F.tid = threadIdx.x; F.lane = F.tid & 63; F.wave = __builtin_amdgcn_readfirstlane(F.tid >> 6); F.G = gridDim.x; F.bid = blockIdx.x; F.ws = P.ws;
    volatile LAS unsigned* MISC = (volatile LAS unsigned*)(F.lds + MISC_OFF);
    if (F.tid < 32) MISC[F.tid] = 0u;
    __syncthreads();
    unsigned* ctl = (unsigned*)(P.ws + WS_CTL);
    XcdBarrier bar = xcd_barrier_post(ctl + CW_BAR, MISC + 8);
    const int lo = P.ph_lo, hi = P.ph_hi; (void)lo; (void)hi; const int G = F.G, c = F.bid;
#define OPAQUE_WS() unsigned char* ws = P.ws; asm volatile("" : "+s"(ws)); F.ws = ws; F.tid = fresh_tid(F.wave); asm volatile("" : "+v"(F.tid)); F.lane = F.tid & 63; int c = F.bid; asm volatile("" : "+s"(c))
#ifdef ONLY
#define PH_EN(j) ((j) == ONLY)
#else
#define PH_EN(j) true
#endif
#if HYBRID == 0
#define IN(k) true
#else
#define IN(k) (lo <= (k) && (k) < hi)
#endif
#define SEAM(k) do { if (IN(k) && IN((k) + 1)) xcd_barrier(bar); } while (0)
#ifndef PROBE_ABL
#define PROBE_ABL 0
#endif
#ifdef PROBE_N
#ifndef PROBE_AFTER
#define PROBE_AFTER 0
#endif
#ifdef PROBE_REAL
#define PROBE_DRY_ 0
#else
#define PROBE_DRY_ 1
#endif
#define REP_BEGIN(k) for (int rep_ = 0, nrep_ = ((k) >= PROBE_LO && (k) < PROBE_HI) ? PROBE_N : 0; rep_ <= nrep_; ++rep_) { const bool rerun = PROBE_AFTER ? (rep_ > 0) : (rep_ < nrep_), dry = rerun && PROBE_DRY_;
#define REP_END(k) if (rep_ < nrep_) xcd_barrier(bar); }
#else
#define REP_BEGIN(k) { constexpr bool dry = false, rerun = false;
#define REP_END(k) }
#endif
#ifndef NO_P0
    if (IN(0)) { REP_BEGIN(0) OPAQUE_WS(); phase_prologue(F, P); (void)dry; REP_END(0) }
#endif
    SEAM(0);
#ifdef PROBE_BARS
    for (int i_ = 0; i_ < PROBE_BARS; ++i_) xcd_barrier(bar);
#endif

#pragma unroll 1
    for (int l = 0; l < DEPTH; ++l) {
        const int pb = 1 + 9 * l;
        if (PH_EN(0) && IN(pb + 0)) { REP_BEGIN(pb + 0) OPAQUE_WS(); int lq = l; asm volatile("" : "+s"(lq));
            if (lq == 0 && !rerun) { phase_dense_w13_b(F, P); xcd_barrier(bar); }
            if (lq > 0) {
                { const int gw = F.bid * NWAVES + F.wave, NGW = F.G * NWAVES; const u64_t* ssq = ssq_ptr(ws, 3 * lq); float* rsq = (float*)(ws + WS_RSQA);
                  quant_pass((const bf16_t*)(ws + WS_XB), ws + AR_XQA, rsq, ssq, gw, NGW, F.lane, dry); }
                xcd_barrier(bar);
            }
            { Sched2D Sg{(const char*)(ws + AR_XQA), (const char*)(ws + WB_WIN + lq * SZ_WIN), NTOK / 256, OFF_GL / 256, D / 2, G, c, 0, (NTOK / 256) * (OFF_GL / 256)};
              EpiIn E{ws, P, lq, dry, rerun};
              pg8::gemm_phase<EpiIn, Sched2D, true, true, true>(F.lds, D / 2, Sg, E, F.wave); }
            { Sched2D Sg{(const char*)(ws + AR_XQA), (const char*)(ws + WB_WIN + lq * SZ_WIN + (size_t)OFF_GL * D), NTOK / 256, 3 * D / 256, D / 2, G, c, 0, (NTOK / 256) * (3 * D / 256)};
              EpiGateI8 E{ws, P, lq, dry};
              pg8::gemm_phase<EpiGateI8, Sched2D, true, true, true>(F.lds, D / 2, Sg, E, F.wave); }
            if (lq == 0) {
                int c2 = c - 128; asm volatile("" : "+s"(c2));
                if (c2 >= 0 && c2 < 64) { const int l2 = c2 >> 5;
                    Sched2D S2{(const char*)(ws + WS_MEMB), (const char*)(ws + WB_WXKV + l2 * SZ_WXKV), B * MEM / 256, 4, D, 32, c2 & 31, 0, 32};
                    EpiBf<1> E2{(bf16_t*)(ws + WS_KXV) + (size_t)l2 * B * MEM * 1024, 1024, (const float*)(ws + WS_RSTDM), 0, dry};
                    pg8::gemm_phase<EpiBf<1>, Sched2D>(F.lds, D, S2, E2, F.wave); }
            }
        REP_END(pb + 0) }
        SEAM(pb + 0);
        if (PH_EN(1) && IN(pb + 1)) { REP_BEGIN(pb + 1) OPAQUE_WS(); int lq = l; asm volatile("" : "+s"(lq));
#ifndef NO_A2
#ifndef PROBE_SUB
#define PROBE_SUB 0
#endif
#ifndef PROBE_ABL
#define PROBE_ABL 0
#endif
            if (!dry || PROBE_SUB == 0 || PROBE_SUB == 3) phase_pool(F, dry);
            if (lq == 0 && !dry) phase_kxnorm(F, P);
            if (!dry || PROBE_SUB == 0 || PROBE_SUB == 1) { att::MobaArgs A{(const bf16_t*)(ws + AR_QA), (const bf16_t*)(ws + AR_KA), (const bf16_t*)(ws + AR_VA), (bf16_t*)(ws + AR_QA), (const float*)(ws + CTL_KMEAN) + (size_t)lq * B * AH * NBLK * HD, (const float*)(ws + WS_LUTA), dry, dry ? PROBE_ABL : 0
#ifdef PROBE_UNITCYC
                , nullptr
#endif
              };
              for (int pi = c, rnd = 0; pi < B * AH * 8; pi += G, ++rnd) { int bh = pi >> 3, s = pi & 7;
                  if (G == 256) { const int x = c & 7, k = c >> 3; bh = x + 8 * (4 * rnd + (k >> 3)); s = (rnd & 1) ? 7 - (k & 7) : (k & 7); }
                  #ifdef PROBE_UNITCYC
                  if (c == 0 && lq == 1 && rnd == 0) A.stamp = (unsigned*)(ws + WS_CTL) + 64;
#endif
                  att::moba_unit(A, bh / AH, bh % AH, 15 - s, F.lds, F.wave, true);
#ifdef PROBE_UNITCYC
                  A.stamp = nullptr;
#endif
                  att::moba_unit(A, bh / AH, bh % AH, s, F.lds, F.wave, false); } }
            if (!dry || PROBE_SUB == 0 || PROBE_SUB == 2) { att::SwaArgs A{(const bf16_t*)(ws + AR_QC), (const bf16_t*)(ws + AR_KC), (const bf16_t*)(ws + AR_VC), (bf16_t*)(ws + AR_QC), (const float*)(ws + WS_LUTC), P.in[12] + lq * CH, dry};
              for (int u = c; u < B * CKV * (S / 64); u += G) { const int qblk = u & 63, kv = (u >> 6) & 1, b = u >> 7; att::swa_unit(A, b, kv, qblk, F.lds, F.wave); } }
            __syncthreads();
#endif
        REP_END(pb + 1) }
        SEAM(pb + 1);
        if (PH_EN(2) && IN(pb + 2)) { REP_BEGIN(pb + 2) OPAQUE_WS(); int lq = l; asm volatile("" : "+s"(lq));
            SchedMerge Sg{ws, lq, NTOK / 256, D / 256, 512, G, c};
            EpiMerge E{ws, dry};
            pg8::gemm_phase<EpiMerge, SchedMerge>(F.lds, 512, Sg, E, F.wave);
        REP_END(pb + 2) }
        SEAM(pb + 2);
        if (PH_EN(3) && IN(pb + 3)) { REP_BEGIN(pb + 3) OPAQUE_WS(); int lq = l; asm volatile("" : "+s"(lq));
            Sched2D Sg{(const char*)(ws + AR_MERGED), (const char*)(ws + WB_WOUT + lq * SZ_WOUT), NTOK / 256, D / 256, D, G, c, 0, (NTOK / 256) * (D / 256)};
            EpiRes E{ws, 3 * lq + 1, dry};
            pg8::gemm_phase<EpiRes, Sched2D>(F.lds, D, Sg, E, F.wave);
        REP_END(pb + 3) }
        SEAM(pb + 3);
        if (PH_EN(4) && IN(pb + 4)) { REP_BEGIN(pb + 4) OPAQUE_WS(); int lq = l; asm volatile("" : "+s"(lq));
            Sched2D Sg{(const char*)(ws + WS_XB), (const char*)(ws + WB_WXQ + lq * SZ_WXQ), NTOK / 256, XW / 256, D, G, c, 0, (NTOK / 256) * (XW / 256)};
            EpiBf<0> E{(bf16_t*)(ws + AR_QX), XW, ssq_ptr(ws, 3 * lq + 1), 0, dry};
            pg8::gemm_phase<EpiBf<0>, Sched2D>(F.lds, D, Sg, E, F.wave);
        REP_END(pb + 4) }
        SEAM(pb + 4);
        if (PH_EN(5) && IN(pb + 5)) { REP_BEGIN(pb + 5) OPAQUE_WS(); int lq = l; asm volatile("" : "+s"(lq));
#ifndef NO_X2
            att::XArgs A{(const bf16_t*)(ws + AR_QX), (const bf16_t*)(ws + WS_KXV) + (size_t)lq * B * MEM * 1024, (bf16_t*)(ws + AR_OX), P.in[20] + lq * XHD, dry};
            for (int u = c, rnd = 0; u < B * XH * (S / 256); u += G, ++rnd) { int qt = u & 15, h = (u >> 4) & 3, b = u >> 6;
                if (G == 256) { const int idx = rnd * 32 + (c >> 3), bh = (c & 7) * 4 + (idx >> 4); qt = idx & 15; h = bh & 3; b = bh >> 2; }
                att::xattn_unit(A, b, h, qt, F.lds, F.wave); }
            __syncthreads();
#endif
        REP_END(pb + 5) }
        SEAM(pb + 5);
        if (PH_EN(6) && IN(pb + 6)) { REP_BEGIN(pb + 6) OPAQUE_WS(); int lq = l; asm volatile("" : "+s"(lq));
            Sched2D Sg{(const char*)(ws + AR_OX), (const char*)(ws + WB_WXO + lq * SZ_WXO), NTOK / 256, D / 256, XW, G, c, 0, (NTOK / 256) * (D / 256)};
            EpiRes E{ws, 3 * lq + 2, dry};
            pg8::gemm_phase<EpiRes, Sched2D>(F.lds, XW, Sg, E, F.wave);
        REP_END(pb + 6) }
        SEAM(pb + 6);
        if (l == 0) {
            if (PH_EN(7) && IN(pb + 7)) { REP_BEGIN(pb + 7) OPAQUE_WS(); int lq = l; asm volatile("" : "+s"(lq));
                { const int gw = F.bid * NWAVES + F.wave, NGW = F.G * NWAVES; const u64_t* ssq = ssq_ptr(ws, 3 * lq + 2); float* rsq = (float*)(ws + WS_RSQ);
                  quant_pass((const bf16_t*)(ws + WS_XB), ws + AR_XQ, rsq, ssq, gw, NGW, F.lane, dry); }
                xcd_barrier(bar);
                Sched2D Sg{(const char*)(ws + AR_XQ), (const char*)(ws + WB_W13), NTOK / 256, 2 * DFF / 256, D / 2, G, c, 0, (NTOK / 256) * (2 * DFF / 256)};
                EpiSwigluI8 E{ws, 0, 0, dry, 0x7fffffff};
                pg8::gemm_phase<EpiSwigluI8, Sched2D, true, true, true>(F.lds, D / 2, Sg, E, F.wave);
            REP_END(pb + 7) }
            SEAM(pb + 7);
            if (PH_EN(8) && IN(pb + 8)) { REP_BEGIN(pb + 8) OPAQUE_WS(); int lq = l; asm volatile("" : "+s"(lq));
                Sched2D Sg{(const char*)(ws + AR_HFF), (const char*)(ws + WB_W2), NTOK / 256, D / 256, DFF / 2, G, c, 0, (NTOK / 256) * (D / 256)};
                EpiResT<true> E{ws, 3 * lq + 3, dry};
                pg8::gemm_phase<EpiResT<true>, Sched2D, true, true, false, true>(F.lds, DFF / 2, Sg, E, F.wave);
            REP_END(pb + 8) }
            SEAM(pb + 8);
        } else {
#ifndef NO_MOE
            if (PH_EN(7) && IN(pb + 7)) { REP_BEGIN(pb + 7) OPAQUE_WS(); int lq = l; asm volatile("" : "+s"(lq)); phase_router(F, P, lq / 2, dry || rerun); phase_moe_weights_a(F, P, lq / 2, dry || rerun); xcd_barrier(bar); phase_moe_weights_b(F, P, lq / 2, dry); phase_moe_gather(F, dry || rerun); REP_END(pb + 7) }
            SEAM(pb + 7);
            if (PH_EN(9) && IN(pb + 9)) { REP_BEGIN(pb + 9) OPAQUE_WS(); int lq = l; asm volatile("" : "+s"(lq));
                LAS int* lpend = (LAS int*)(F.lds + MISC_OFF + 64);
                { int pend[NE], pstart[NE], cnt[NE]; moe_pends(F, pend, pstart, cnt);
                  if (F.tid == 0) {
#pragma unroll
                      for (int e = 0; e < NE; ++e) lpend[e] = pend[e]; } }
                __syncthreads();
                const int R = __builtin_amdgcn_readfirstlane(lpend[NE - 1]) / 256;
                const int nfull = R / MOE_CHUNK_RB, rem0 = nfull * MOE_CHUNK_RB, rem = R - rem0; const bool tail = (rem > 0 && rem <= 16 && nfull >= 2);
                const int nchunk = tail ? nfull : (R + MOE_CHUNK_RB - 1) / MOE_CHUNK_RB;
#pragma unroll 1
                for (int k = 0; k < nchunk; ++k) { const int rb0 = k * MOE_CHUNK_RB, rb1 = (rb0 + MOE_CHUNK_RB < R) ? rb0 + MOE_CHUNK_RB : R;
                    const int nside = (tail && k == 1) ? 4 * rem : 0;
                    if (c < nside) { SchedMoe<false> Sg{ws, lpend, rem0, R, 0, 0, nside, c, 1};
                      EpiBf<3> E{(bf16_t*)(ws + AR_Y), D, (const unsigned*)(ws + CTL_AMAX) + AMAX_W2 + 1, 0, dry};
                      pg8::gemm_phase<EpiBf<3>, SchedMoe<false>, true, true, false, true>(F.lds, DFF / 2, Sg, E, F.wave); }
                    else { SchedMoe<true> Sg{ws, lpend, rb0, rb1, (tail && k == 0) ? rem0 : 0, (tail && k == 0) ? R : 0, G - nside, c - nside, 0};
                      EpiSwigluI8 E{ws, 1, rb0 * 256, dry, (tail && k == 0) ? rem0 * 256 : 0x7fffffff};
                      pg8::gemm_phase<EpiSwigluI8, SchedMoe<true>, true, true, true>(F.lds, D / 2, Sg, E, F.wave); }
                    xcd_barrier(bar);
                    { SchedMoe<false> Sg{ws, lpend, rb0, rb1, 0, 0, G, c, 0};
                      EpiBf<3> E{(bf16_t*)(ws + AR_Y), D, (const unsigned*)(ws + CTL_AMAX) + AMAX_W2 + 1, 0, dry};
                      pg8::gemm_phase<EpiBf<3>, SchedMoe<false>, true, true, false, true>(F.lds, DFF / 2, Sg, E, F.wave); }
                    xcd_barrier(bar);
                }
                F.tid = fresh_tid(F.wave); asm volatile("" : "+v"(F.tid)); F.lane = F.tid & 63;
                phase_moe_combine(F, P, dry);
#ifdef PROBE_UNITCYC
                if (c == 0 && F.tid == 0) P.out[0] += __uint_as_float(((const unsigned*)(ws + WS_CTL))[64]);
#endif
            REP_END(pb + 9) }
            if (l + 1 < DEPTH) SEAM(pb + 9);
#endif
        }
    }
#undef IN
#undef SEAM
}

struct Launcher { int grid = 0; };
inline int setup_grid() {
    static int grid = 0;
    if (grid == 0) { int dev = 0, cus = 0; if (hipGetDevice(&dev) != hipSuccess || hipDeviceGetAttribute(&cus, hipDeviceAttributeMultiprocessorCount, dev) != hipSuccess) { grid = -1; return grid; }
        if (hipFuncSetAttribute((const void*)mk_fwd, hipFuncAttributeMaxDynamicSharedMemorySize, LDS_BYTES) != hipSuccess) { grid = -1; return grid; }
        int per_cu = 0; (void)hipOccupancyMaxActiveBlocksPerMultiprocessor(&per_cu, (const void*)mk_fwd, NTHREADS, LDS_BYTES); (void)hipGetLastError();
        grid = (per_cu >= 1) ? cus : -1; }
    return grid;
}
inline void launch_phases(void* const* d_in, float* out, unsigned char* ws, int lo, int hi, int src_is_out, int entry_v, hipStream_t st) {
    const int grid = setup_grid(); if (grid <= 0) return;
    (void)hipMemsetAsync(ws + WS_CTL + (size_t)CW_BAR * 4, 0, (size_t)XCD_BAR_WORDS * 4, st);
    Params p{}; for (int i = 0; i < 31; ++i) p.in[i] = (const float*)d_in[i];
    p.out = out; p.ws = ws; p.ph_lo = lo; p.ph_hi = hi; p.src_is_out = src_is_out; p.entry_v = entry_v;
    hipLaunchKernelGGL(mk_fwd, dim3(grid), dim3(NTHREADS), LDS_BYTES, st, p);
}
}
extern "C" void kernel_launch(void* const* d_in, const int* in_sizes, int n_in, void* d_out, int out_size, void* d_ws, size_t ws_size, hipStream_t stream) {
    if (n_in != 31 || out_size != cfg::NTOK * cfg::D || ws_size < fk::WS_NEED) return;
    unsigned char* ws = (unsigned char*)d_ws; float* out = (float*)d_out;
    (void)hipMemsetAsync(ws + fk::WS_CTL, 0, fk::CTL_BYTES, stream);
#if HYBRID == 0
    fk::launch_phases(d_in, out, ws, 0, fk::N_PHASES, 0, 0, stream);
#elif HYBRID == 1
    fk::launch_phases(d_in, out, ws, 0, 5, 0, 0, stream);
    nv::forward(d_in, out, (char*)d_ws, stream, 0, 1);
#elif HYBRID == 2
    fk::launch_phases(d_in, out, ws, 0, 10, 0, 0, stream);
    nv::forward(d_in, out, (char*)d_ws, stream, 1, 0);
#elif HYBRID == 3
    fk::launch_phases(d_in, out, ws, 0, 17, 0, 0, stream);
    nv::forward(d_in, out, (char*)d_ws, stream, 1, 2);
#endif
}
```
